# Optimizing an MI355X kernel written in HIP

```python
import math
import jax, jax.numpy as jnp
from jax import lax
import numpy as np

D_MODEL = 4096
BATCH = 2
SEQ = 4096
DEPTH = 1

CHUNK = 64
HEAD_DIM = 128
MIX_WIDTH = D_MODEL
FOX_HEADS = MIX_WIDTH // (2 * HEAD_DIM)
GDN_HEADS = MIX_WIDTH // (2 * HEAD_DIM)
FOX_WIDTH = FOX_HEADS * HEAD_DIM
GDN_WIDTH = GDN_HEADS * HEAD_DIM
Q_BLOCK = 128
CONV_K = 4
D_FF = ((8 * D_MODEL + 767) // 768) * 256
N_MOD = 6
EPS = 1e-6

OFF_FOX_Q = 0
OFF_FOX_K = OFF_FOX_Q + FOX_WIDTH
OFF_FOX_V = OFF_FOX_K + FOX_WIDTH
OFF_FOX_F = OFF_FOX_V + FOX_WIDTH
OFF_GDN_QKV = OFF_FOX_F + FOX_HEADS
OFF_GDN_A = OFF_GDN_QKV + 3 * GDN_WIDTH
OFF_GDN_B = OFF_GDN_A + GDN_HEADS
OFF_GDN_Z = OFF_GDN_B + GDN_HEADS
IN_COLS = OFF_GDN_Z + GDN_WIDTH

kernel_name = "hybrid_fox_gdn_adaln_block"


def rms_norm(x, gain):
    xf = x.astype(jnp.float32)
    y = xf * lax.rsqrt(jnp.mean(xf * xf, axis=-1, keepdims=True) + EPS)
    return (y * gain.astype(jnp.float32)).astype(x.dtype)


def l2_normalize(x):
    xf = x.astype(jnp.float32)
    return xf * lax.rsqrt(jnp.sum(xf * xf, axis=-1, keepdims=True) + EPS)


def split_heads(t, n_heads):
    return t.reshape(t.shape[0], t.shape[1], n_heads, -1)


def forgetting_attention(q, k, v, f_logit):
    B, S, H, D = q.shape
    nb = S // Q_BLOCK
    cum = jnp.cumsum(jax.nn.log_sigmoid(f_logit.astype(jnp.float32)), axis=1)
    cum = cum.transpose(0, 2, 1)
    qh, kh, vh = (t.transpose(0, 2, 1, 3) for t in (q, k, v))
    q_blocks = qh.reshape(B, H, nb, Q_BLOCK, D).transpose(2, 0, 1, 3, 4)
    c_blocks = cum.reshape(B, H, nb, Q_BLOCK).transpose(2, 0, 1, 3)
    p_blocks = jnp.arange(S, dtype=jnp.int32).reshape(nb, Q_BLOCK)
    k_pos = jnp.arange(S, dtype=jnp.int32)
    scale = D ** -0.5

    def one_block(args):
        qb, cb, pb = args
        s = jnp.einsum('bhqd,bhkd->bhqk', qb, kh, preferred_element_type=jnp.float32) * scale
        s = s + (cb[..., :, None] - cum[:, :, None, :])
        s = jnp.where(k_pos[None, :] <= pb[:, None], s, -jnp.inf)
        p = jax.nn.softmax(s, axis=-1)
        return jnp.einsum('bhqk,bhkd->bhqd', p.astype(vh.dtype), vh)

    out = lax.map(one_block, (q_blocks, c_blocks, p_blocks))
    return out.transpose(1, 0, 3, 2, 4).reshape(B, S, H * D)


def causal_short_conv(x, w):
    S = x.shape[1]
    xp = jnp.pad(x, ((0, 0), (CONV_K - 1, 0), (0, 0)))
    y = xp[:, 0:S] * w[0]
    for i in range(1, CONV_K):
        y = y + xp[:, i:i + S] * w[i]
    return jax.nn.silu(y)


def chunked_gated_delta_rule(q, k, v, g, beta):
    B, S, H, Dk = q.shape
    Dv = v.shape[-1]
    n = S // CHUNK

    def chunks(t):
        t = jnp.moveaxis(t.astype(jnp.float32), 2, 1)
        return t.reshape((B, H, n, CHUNK) + t.shape[3:])

    q = chunks(q) * (Dk ** -0.5)
    k = chunks(k)
    v = chunks(v)
    beta = chunks(beta)
    g = jnp.cumsum(chunks(g), axis=-1)
    idx = jnp.arange(CHUNK)
    lower = idx[:, None] >= idx[None, :]
    strict = idx[:, None] > idx[None, :]
    decay = jnp.exp(jnp.where(lower, g[..., :, None] - g[..., None, :], -jnp.inf))
    k_beta = k * beta[..., None]
    kk = jnp.einsum('bhnid,bhnjd->bhnij', k_beta, k) * decay
    a_mat = jnp.where(strict, kk, 0.0) + jnp.eye(CHUNK, dtype=jnp.float32)

    def solve(rhs):
        return lax.linalg.triangular_solve(a_mat, rhs, left_side=True, lower=True,
                                           unit_diagonal=True)

    u = solve(v * beta[..., None])
    w = solve(k_beta * jnp.exp(g)[..., None])
    intra = jnp.where(lower, jnp.einsum('bhnid,bhnjd->bhnij', q, k) * decay, 0.0)
    q_dec = q * jnp.exp(g)[..., None]
    k_tail = k * jnp.exp(g[..., -1:] - g)[..., None]
    g_tot = jnp.exp(g[..., -1])

    def step(state, xs):
        u_i, w_i, q_i, k_i, a_i, gt_i = xs
        v_new = u_i - jnp.einsum('bhck,bhkv->bhcv', w_i, state)
        o_i = (jnp.einsum('bhck,bhkv->bhcv', q_i, state)
               + jnp.einsum('bhcj,bhjv->bhcv', a_i, v_new))
        state = state * gt_i[..., None, None] + jnp.einsum('bhck,bhcv->bhkv', k_i, v_new)
        return state, o_i

    xs = tuple(jnp.moveaxis(t, 2, 0) for t in (u, w, q_dec, k_tail, intra, g_tot))
    state0 = jnp.zeros((B, H, Dk, Dv), jnp.float32)
    _, o = lax.scan(step, state0, xs)
    return o.transpose(1, 0, 3, 2, 4).reshape(B, S, H, Dv)


def hybrid_mixer(h, w_in, fox_q_norm, fox_k_norm, fox_f_bias,
                 gdn_conv_w, gdn_a_log, gdn_dt_bias, gdn_norm_w):
    B, S, _ = h.shape
    p = h @ w_in
    fq = rms_norm(split_heads(p[..., OFF_FOX_Q:OFF_FOX_K], FOX_HEADS), fox_q_norm)
    fk = rms_norm(split_heads(p[..., OFF_FOX_K:OFF_FOX_V], FOX_HEADS), fox_k_norm)
    fv = split_heads(p[..., OFF_FOX_V:OFF_FOX_F], FOX_HEADS)
    f_logit = p[..., OFF_FOX_F:OFF_GDN_QKV] + fox_f_bias
    y_fox = forgetting_attention(fq, fk, fv, f_logit).astype(h.dtype)
    qkv = causal_short_conv(p[..., OFF_GDN_QKV:OFF_GDN_A], gdn_conv_w)
    gq, gk, gv = (split_heads(t, GDN_HEADS) for t in jnp.split(qkv, 3, axis=-1))
    gq = l2_normalize(gq)
    gk = l2_normalize(gk)
    a = p[..., OFF_GDN_A:OFF_GDN_B].astype(jnp.float32)
    g = -jnp.exp(gdn_a_log.astype(jnp.float32)) * jax.nn.softplus(a + gdn_dt_bias.astype(jnp.float32))
    beta = jax.nn.sigmoid(p[..., OFF_GDN_B:OFF_GDN_Z].astype(jnp.float32))
    o = chunked_gated_delta_rule(gq, gk, gv, g, beta)
    z = split_heads(p[..., OFF_GDN_Z:IN_COLS], GDN_HEADS).astype(jnp.float32)
    y_gdn = (rms_norm(o, gdn_norm_w) * jax.nn.silu(z)).reshape(B, S, GDN_WIDTH).astype(h.dtype)
    return jnp.concatenate([y_fox, y_gdn], axis=-1)


def swiglu(h, w_gate, w_up, w_down):
    return (jax.nn.silu(h @ w_gate) * (h @ w_up)) @ w_down


def setup_inputs(seed: int = 0) -> dict:
    key = jax.random.key(seed)
    ks = jax.random.split(key, 20)
    f32 = jnp.float32

    def normal(k, shape, scale):
        return jax.random.normal(k, shape, f32) * scale

    x = normal(ks[0], (BATCH, SEQ, D_MODEL), 1.0)
    c = normal(ks[1], (BATCH, D_MODEL), 1.0)
    w_ada = normal(ks[2], (DEPTH, D_MODEL, N_MOD * D_MODEL), 0.5 * D_MODEL ** -0.5)
    b_ada = normal(ks[3], (DEPTH, N_MOD * D_MODEL), 0.02)
    norm1_g = 1.0 + normal(ks[4], (DEPTH, D_MODEL), 0.02)
    w_in = normal(ks[5], (DEPTH, D_MODEL, IN_COLS), D_MODEL ** -0.5)
    fox_q_norm = 1.0 + normal(ks[6], (DEPTH, HEAD_DIM), 0.02)
    fox_k_norm = 1.0 + normal(ks[7], (DEPTH, HEAD_DIM), 0.02)
    fox_f_bias = 3.0 + normal(ks[8], (DEPTH, FOX_HEADS), 0.5)
    gdn_conv_w = normal(ks[9], (DEPTH, CONV_K, 3 * GDN_WIDTH), CONV_K ** -0.5)
    gdn_a_log = jnp.log(jax.random.uniform(ks[10], (DEPTH, GDN_HEADS), f32, 1.0, 16.0))
    dt = jnp.exp(jax.random.uniform(ks[11], (DEPTH, GDN_HEADS), f32,
                                    math.log(1e-3), math.log(1e-1)))
    gdn_dt_bias = dt + jnp.log(-jnp.expm1(-dt))
    gdn_norm_w = 1.0 + normal(ks[12], (DEPTH, HEAD_DIM), 0.02)
    w_out = normal(ks[13], (DEPTH, MIX_WIDTH, D_MODEL), MIX_WIDTH ** -0.5)
    norm2_g = 1.0 + normal(ks[14], (DEPTH, D_MODEL), 0.02)
    w_gate = normal(ks[15], (DEPTH, D_MODEL, D_FF), D_MODEL ** -0.5)
    w_up = normal(ks[16], (DEPTH, D_MODEL, D_FF), D_MODEL ** -0.5)
    w_down = normal(ks[17], (DEPTH, D_FF, D_MODEL), D_FF ** -0.5)
    return {"x": x, "c": c, "w_ada": w_ada, "b_ada": b_ada, "norm1_g": norm1_g,
            "w_in": w_in, "fox_q_norm": fox_q_norm, "fox_k_norm": fox_k_norm,
            "fox_f_bias": fox_f_bias, "gdn_conv_w": gdn_conv_w, "gdn_a_log": gdn_a_log,
            "gdn_dt_bias": gdn_dt_bias, "gdn_norm_w": gdn_norm_w, "w_out": w_out,
            "norm2_g": norm2_g, "w_gate": w_gate, "w_up": w_up, "w_down": w_down}


def reference(x, c, w_ada, b_ada, norm1_g, w_in, fox_q_norm, fox_k_norm, fox_f_bias,
              gdn_conv_w, gdn_a_log, gdn_dt_bias, gdn_norm_w, w_out, norm2_g,
              w_gate, w_up, w_down):
    cond = jax.nn.silu(c)
    for l in range(DEPTH):
        mod = cond @ w_ada[l] + b_ada[l]
        sh1, sc1, g1, sh2, sc2, g2 = [m[:, None, :] for m in jnp.split(mod, N_MOD, axis=-1)]
        h = rms_norm(x, norm1_g[l]) * (1 + sc1) + sh1
        mix = hybrid_mixer(h, w_in[l], fox_q_norm[l], fox_k_norm[l], fox_f_bias[l],
                           gdn_conv_w[l], gdn_a_log[l], gdn_dt_bias[l], gdn_norm_w[l])
        x = x + g1 * (mix @ w_out[l])
        h = rms_norm(x, norm2_g[l]) * (1 + sc2) + sh2
        x = x + g2 * swiglu(h, w_gate[l], w_up[l], w_down[l])
    return x
```

```cpp
#include <hip/hip_runtime.h>
#include <cstdio>
#include <cstdint>
namespace pg8 {
#define PG8_LAS __attribute__((address_space(3)))
typedef unsigned short bf16_t;
typedef short bf16x8 __attribute__((ext_vector_type(8)));
typedef float f32x4 __attribute__((ext_vector_type(4)));
typedef unsigned u32x4 __attribute__((ext_vector_type(4)));
constexpr int BM = 256, BK = 64, HALF = 128, HTB = HALF * BK * 2  , STAGE_BYTES = 8 * HTB, NXCD = 8, WGM = 8;

__host__ __device__ __forceinline__ int lds_byte(int r, int c) { const int st = (r >> 4) * 2 + (c >> 5), rr = r & 15, cc = c & 31, ob = rr * 64 + cc * 2; return st * 1024 + (ob ^ (((ob >> 9) & 1) << 5)); }
__host__ __device__ __forceinline__ void stage_rc(int b, int& R, int& C) { const int st = b / 1024, sb = b % 1024, swz = sb ^ (((sb >> 9) & 1) << 5); R = (st >> 1) * 16 + swz / 64; C = (st & 1) * 32 + (swz % 64) / 2; }
__host__ __device__ __forceinline__ int perm32(int rho) { const int n = rho >> 4, i = rho & 15; return 8 * (i >> 2) + 4 * n + (i & 3); }

struct Unit { int pm, pn; };
struct Gemm { const bf16_t* A; const bf16_t* Bt; int M, N, K, ld; };

struct StaticOrder {
    int nM, nN, nwg, G, c;
    __host__ __device__ void init(int M, int N, int G_, int c_) { nM = M / BM; nN = N / BM; nwg = nM * nN; G = G_; c = c_; }
    __host__ __device__ bool next(int i, Unit& u) const {
        const long L = (long)i * G + c; if (L >= nwg) return false;
        int wgid = (int)L; { const int q = nwg / NXCD, r = nwg % NXCD, xcd = wgid % NXCD, off = wgid / NXCD; wgid = (xcd < r ? xcd * (q + 1) : r * (q + 1) + (xcd - r) * q) + off; }
        const int nig = WGM * nN, gid = wgid / nig, fm = gid * WGM, gsz = (nM - fm) < WGM ? (nM - fm) : WGM;
        u.pm = fm + ((wgid % nig) % gsz); u.pn = (wgid % nig) / gsz; return true;
    }
    __device__ __forceinline__ void a_ready(const Unit&) const {}
    __device__ __forceinline__ void done(const Unit&) const {}
};

__device__ __forceinline__ unsigned cvt_pk_bf16(float lo, float hi) { unsigned r; asm volatile("v_cvt_pk_bf16_f32 %0, %1, %2" : "=v"(r) : "v"(lo), "v"(hi)); return r; }
typedef float f32x2 __attribute__((ext_vector_type(2)));
__device__ __forceinline__ f32x2 gelu_pk(f32x2 v) {
    const f32x2 av = __builtin_elementwise_abs(v), d = av * 0.2316418882f + 1.0f;
    f32x2 t; t.x = __builtin_amdgcn_rcpf(d.x); t.y = __builtin_amdgcn_rcpf(d.y);
    f32x2 q = t * 0.5307027145f + (-0.7265760135f); q = q * t + 0.7107068705f; q = q * t + (-0.142248368f); q = q * t + 0.127414796f; q = q * t;
    const f32x2 s = (v * v) * (-0.72134752044f);
    f32x2 e; e.x = __builtin_amdgcn_exp2f(s.x); e.y = __builtin_amdgcn_exp2f(s.y);
    const f32x2 m = v * (q * e), r = v - m;
    f32x2 o; o.x = v.x < 0.f ? m.x : r.x; o.y = v.y < 0.f ? m.y : r.y; return o;
}

template <int ACT  > struct EpiBf16 {
    static constexpr bool PERM = true, AFTER_DRAIN = false; static_assert(ACT == 0 || ACT == 1, "EpiBf16: ACT is 0 (none) or 1 (gelu_pk)");
    bf16_t* O; int ldc; const float* bias; int split_cols; size_t split_stride; float scale0;
    __device__ __forceinline__ void operator()(const f32x4 (&acc)[2][2][4][2], const Unit& u, int wr, int wc, int fr, int fq) const {
        const int row0 = u.pm * BM + wr * 64 + fr; int colt = u.pn * BM; bf16_t* base = O;
        float sc = 1.f; if (split_cols) { const int t = colt / split_cols; base += (size_t)t * split_stride; colt -= t * split_cols; if (t == 0) sc = scale0; }
        const int col0 = colt + wc * 32 + 8 * fq, bcol0 = u.pn * BM + wc * 32 + 8 * fq;
        f32x4 bv[2][2];
#pragma unroll
        for (int bj = 0; bj < 2; ++bj)
#pragma unroll
            for (int n = 0; n < 2; ++n) bv[bj][n] = bias ? *(const f32x4*)(bias + bcol0 + bj * HALF + 4 * n) : (f32x4){0.f, 0.f, 0.f, 0.f};
#pragma unroll
        for (int ai = 0; ai < 2; ++ai)
#pragma unroll
            for (int m = 0; m < 4; ++m) { bf16_t* rowp = base + (size_t)(row0 + ai * HALF + m * 16) * ldc + col0;
#pragma unroll
                for (int bj = 0; bj < 2; ++bj) { f32x4 v0 = acc[ai][bj][m][0] + bv[bj][0], v1 = acc[ai][bj][m][1] + bv[bj][1];
                    if (ACT == 1) { f32x2 a = gelu_pk((f32x2){v0[0], v0[1]}), b = gelu_pk((f32x2){v0[2], v0[3]}), c = gelu_pk((f32x2){v1[0], v1[1]}), d = gelu_pk((f32x2){v1[2], v1[3]});
                        v0 = (f32x4){a.x, a.y, b.x, b.y}; v1 = (f32x4){c.x, c.y, d.x, d.y}; }
                    v0 = v0 * sc; v1 = v1 * sc; u32x4 w; w.x = cvt_pk_bf16(v0[0], v0[1]); w.y = cvt_pk_bf16(v0[2], v0[3]); w.z = cvt_pk_bf16(v1[0], v1[1]); w.w = cvt_pk_bf16(v1[2], v1[3]);
                    *(u32x4*)(rowp + bj * HALF) = w; } }
    }
};

struct EpiResGate {
    static constexpr bool PERM = false, AFTER_DRAIN = false;
    const float* base; float* out; int ldc; const float* gate; int gate_stride; int rows_per_batch;
    __device__ __forceinline__ void operator()(const f32x4 (&acc)[2][2][4][2], const Unit& u, int wr, int wc, int fr, int fq) const {
        const int col0 = u.pn * BM + wc * 32 + 4 * fq;
        const int b = (u.pm * BM) / rows_per_batch;
        const float* gp = gate + (size_t)b * gate_stride + col0;
        f32x4 gv[2][2];
#pragma unroll
        for (int bj = 0; bj < 2; ++bj)
#pragma unroll
            for (int n = 0; n < 2; ++n) gv[bj][n] = *(const f32x4*)(gp + bj * HALF + n * 16);
        const size_t row0 = (size_t)(u.pm * BM + wr * 64 + fr) * ldc + col0;
        f32x4 bs[2][2][2];
#pragma unroll
        for (int bj = 0; bj < 2; ++bj)
#pragma unroll
            for (int n = 0; n < 2; ++n) bs[0][bj][n] = *(const f32x4*)(base + row0 + bj * HALF + n * 16);
#pragma unroll
        for (int g = 0; g < 8; ++g) { const int ai = g >> 2, m = g & 3; const size_t off = row0 + (size_t)(ai * HALF + m * 16) * ldc;
            if (g < 7) { const size_t offn = row0 + (size_t)(((g + 1) >> 2) * HALF + ((g + 1) & 3) * 16) * ldc;
#pragma unroll
                for (int bj = 0; bj < 2; ++bj)
#pragma unroll
                    for (int n = 0; n < 2; ++n) bs[(g + 1) & 1][bj][n] = *(const f32x4*)(base + offn + bj * HALF + n * 16); }
#pragma unroll
            for (int bj = 0; bj < 2; ++bj)
#pragma unroll
                for (int n = 0; n < 2; ++n) *(f32x4*)(out + off + bj * HALF + n * 16) = bs[g & 1][bj][n] + gv[bj][n] * acc[ai][bj][m][n];
        }
    }
};
struct EpiSwiGLU {
    static constexpr bool PERM = true, AFTER_DRAIN = false;
    bf16_t* O; int ldo;
    __device__ __forceinline__ static float silu_mul(float g, float u) { return g * __builtin_amdgcn_rcpf(1.0f + __builtin_amdgcn_exp2f(-1.4426950408889634f * g)) * u; }
    __device__ __forceinline__ void operator()(const f32x4 (&acc)[2][2][4][2], const Unit& u, int wr, int wc, int fr, int fq) const {
        const int row0 = u.pm * BM + wr * 64 + fr, col0 = u.pn * HALF + wc * 32 + 8 * fq;
#pragma unroll
        for (int ai = 0; ai < 2; ++ai)
#pragma unroll
            for (int m = 0; m < 4; ++m) { bf16_t* rowp = O + (size_t)(row0 + ai * HALF + m * 16) * ldo + col0;
                const f32x4 g0 = acc[ai][0][m][0], g1 = acc[ai][0][m][1], u0 = acc[ai][1][m][0], u1 = acc[ai][1][m][1];
                u32x4 w;
                w.x = cvt_pk_bf16(silu_mul(g0[0], u0[0]), silu_mul(g0[1], u0[1])); w.y = cvt_pk_bf16(silu_mul(g0[2], u0[2]), silu_mul(g0[3], u0[3]));
                w.z = cvt_pk_bf16(silu_mul(g1[0], u1[0]), silu_mul(g1[1], u1[1])); w.w = cvt_pk_bf16(silu_mul(g1[2], u1[2]), silu_mul(g1[3], u1[3]));
                *(u32x4*)rowp = w; }
    }
};
struct EpiSplit {
    static constexpr bool PERM = false, AFTER_DRAIN = false;
    float* SP; int rows;
    __device__ __forceinline__ void operator()(const f32x4 (&acc)[2][2][4][2], const Unit& u, int wr, int wc, int fr, int fq) const {
        if ((((fr >> 2) ^ fq) & 1) != 0) return;
        const int ks = fr & 7, e = fr & 3;
        float* base = SP + (size_t)ks * rows * 64;
#pragma unroll
        for (int ai = 0; ai < 2; ++ai)
#pragma unroll
            for (int m = 0; m < 4; ++m) { const int row_o = 32 * u.pm + 16 * ai + 8 * wr + 2 * m + (fr >> 3);
#pragma unroll
                for (int bj = 0; bj < 2; ++bj)
#pragma unroll
                    for (int n = 0; n < 2; ++n) { const int col_o = 32 * u.pn + 16 * bj + 4 * wc + 2 * n + (fq >> 1);
                        const f32x4 v = acc[ai][bj][m][n];
                        base[(size_t)row_o * 64 + col_o] = e == 0 ? v[0] : (e == 1 ? v[1] : (e == 2 ? v[2] : v[3])); } }
    }
};
struct EpiResGateToBf16 {
    static constexpr bool PERM = true, AFTER_DRAIN = false;
    const float* base; bf16_t* out; int ldc; const float* gate; int gate_stride; int rows_per_batch;
    __device__ __forceinline__ void operator()(const f32x4 (&acc)[2][2][4][2], const Unit& u, int wr, int wc, int fr, int fq) const {
        const int col0 = u.pn * BM + wc * 32 + 8 * fq;
        const int b = (u.pm * BM) / rows_per_batch;
        const float* gp = gate + (size_t)b * gate_stride + col0;
        f32x4 gv[2][2];
#pragma unroll
        for (int bj = 0; bj < 2; ++bj)
#pragma unroll
            for (int n = 0; n < 2; ++n) gv[bj][n] = *(const f32x4*)(gp + bj * HALF + 4 * n);
        const size_t row0 = (size_t)(u.pm * BM + wr * 64 + fr) * ldc + col0;
        f32x4 bs[2][2][2];
#pragma unroll
        for (int bj = 0; bj < 2; ++bj)
#pragma unroll
            for (int n = 0; n < 2; ++n) bs[0][bj][n] = *(const f32x4*)(base + row0 + bj * HALF + 4 * n);
#pragma unroll
        for (int g = 0; g < 8; ++g) { const int ai = g >> 2, m = g & 3; const size_t off = row0 + (size_t)(ai * HALF + m * 16) * ldc;
            if (g < 7) { const size_t offn = row0 + (size_t)(((g + 1) >> 2) * HALF + ((g + 1) & 3) * 16) * ldc;
#pragma unroll
                for (int bj = 0; bj < 2; ++bj)
#pragma unroll
                    for (int n = 0; n < 2; ++n) bs[(g + 1) & 1][bj][n] = *(const f32x4*)(base + offn + bj * HALF + 4 * n); }
#pragma unroll
            for (int bj = 0; bj < 2; ++bj) { const f32x4 v0 = bs[g & 1][bj][0] + gv[bj][0] * acc[ai][bj][m][0], v1 = bs[g & 1][bj][1] + gv[bj][1] * acc[ai][bj][m][1];
                u32x4 w; w.x = cvt_pk_bf16(v0[0], v0[1]); w.y = cvt_pk_bf16(v0[2], v0[3]); w.z = cvt_pk_bf16(v1[0], v1[1]); w.w = cvt_pk_bf16(v1[2], v1[3]);
                *(u32x4*)(out + off + bj * HALF) = w; }
        }
    }
};
struct EpiResGateFromBf16 {
    static constexpr bool PERM = true, AFTER_DRAIN = false;
    const bf16_t* base; float* out; int ldc; const float* gate; int gate_stride; int rows_per_batch;
    __device__ __forceinline__ void operator()(const f32x4 (&acc)[2][2][4][2], const Unit& u, int wr, int wc, int fr, int fq) const {
        const int col0 = u.pn * BM + wc * 32 + 8 * fq;
        const int b = (u.pm * BM) / rows_per_batch;
        const float* gp = gate + (size_t)b * gate_stride + col0;
        f32x4 gv[2][2];
#pragma unroll
        for (int bj = 0; bj < 2; ++bj)
#pragma unroll
            for (int n = 0; n < 2; ++n) gv[bj][n] = *(const f32x4*)(gp + bj * HALF + 4 * n);
        const size_t row0 = (size_t)(u.pm * BM + wr * 64 + fr) * ldc + col0;
        u32x4 bs[2][2];
#pragma unroll
        for (int bj = 0; bj < 2; ++bj) bs[0][bj] = *(const u32x4*)(base + row0 + bj * HALF);
#pragma unroll
        for (int g = 0; g < 8; ++g) { const int ai = g >> 2, m = g & 3; const size_t off = row0 + (size_t)(ai * HALF + m * 16) * ldc;
            if (g < 7) { const size_t offn = row0 + (size_t)(((g + 1) >> 2) * HALF + ((g + 1) & 3) * 16) * ldc;
#pragma unroll
                for (int bj = 0; bj < 2; ++bj) bs[(g + 1) & 1][bj] = *(const u32x4*)(base + offn + bj * HALF); }
#pragma unroll
            for (int bj = 0; bj < 2; ++bj) { const u32x4 w = bs[g & 1][bj];
                const f32x4 x0 = {__builtin_bit_cast(float, w.x << 16), __builtin_bit_cast(float, w.x & 0xffff0000u), __builtin_bit_cast(float, w.y << 16), __builtin_bit_cast(float, w.y & 0xffff0000u)};
                const f32x4 x1 = {__builtin_bit_cast(float, w.z << 16), __builtin_bit_cast(float, w.z & 0xffff0000u), __builtin_bit_cast(float, w.w << 16), __builtin_bit_cast(float, w.w & 0xffff0000u)};
                *(f32x4*)(out + off + bj * HALF) = x0 + gv[bj][0] * acc[ai][bj][m][0];
                *(f32x4*)(out + off + bj * HALF + 4) = x1 + gv[bj][1] * acc[ai][bj][m][1]; }
        }
    }
};
struct EpiBf16QK {
    static constexpr bool PERM = true, AFTER_DRAIN = false;
    bf16_t* O; int ldc; const float* qg; const float* kg; PG8_LAS float* part;
    __device__ __forceinline__ void operator()(const f32x4 (&acc)[2][2][4][2], const Unit& u, int wr, int wc, int fr, int fq) const {
        const int row0 = u.pm * BM + wr * 64 + fr, col0 = u.pn * BM + wc * 32 + 8 * fq;
        const bool normed = u.pn < 16;
        f32x4 g0 = {1.f, 1.f, 1.f, 1.f}, g1 = g0;
        if (normed) {
            const float* gp = (u.pn < 8 ? qg : kg) + wc * 32 + 8 * fq; g0 = *(const f32x4*)gp; g1 = *(const f32x4*)(gp + 4);
#pragma unroll
            for (int ai = 0; ai < 2; ++ai)
#pragma unroll
                for (int m = 0; m < 4; ++m)
#pragma unroll
                    for (int bj = 0; bj < 2; ++bj) { const f32x4 v0 = acc[ai][bj][m][0], v1 = acc[ai][bj][m][1];
                        float ss = ((v0[0] * v0[0] + v0[1] * v0[1]) + (v0[2] * v0[2] + v0[3] * v0[3])) + ((v1[0] * v1[0] + v1[1] * v1[1]) + (v1[2] * v1[2] + v1[3] * v1[3]));
                        ss += __shfl_xor(ss, 16); ss += __shfl_xor(ss, 32);
                        if (fq == 0) part[((ai * HALF + wr * 64 + m * 16 + fr) * 2 + bj) * 4 + wc] = ss; }
            asm volatile("s_waitcnt lgkmcnt(0)" ::: "memory"); __builtin_amdgcn_s_barrier(); asm volatile("" ::: "memory");
        }
#pragma unroll
        for (int ai = 0; ai < 2; ++ai)
#pragma unroll
            for (int m = 0; m < 4; ++m) { bf16_t* rowp = O + (size_t)(row0 + ai * HALF + m * 16) * ldc + col0;
#pragma unroll
                for (int bj = 0; bj < 2; ++bj) { f32x4 v0 = acc[ai][bj][m][0] + 0.f, v1 = acc[ai][bj][m][1] + 0.f;
                    if (normed) { const f32x4 p = *(const PG8_LAS f32x4*)(part + ((ai * HALF + wr * 64 + m * 16 + fr) * 2 + bj) * 4);
                        const float rstd = 1.0f / sqrtf(((p[0] + p[1]) + (p[2] + p[3])) * (1.0f / 128.0f) + 1e-6f);
                        v0 = v0 * rstd * g0; v1 = v1 * rstd * g1; }
                    u32x4 w; w.x = cvt_pk_bf16(v0[0], v0[1]); w.y = cvt_pk_bf16(v0[2], v0[3]); w.z = cvt_pk_bf16(v1[0], v1[1]); w.w = cvt_pk_bf16(v1[2], v1[3]);
                    *(u32x4*)(rowp + bj * HALF) = w; } }
    }
};
struct EpiBf16QKL {
    static constexpr bool PERM = true, AFTER_DRAIN = false, BADJ = true;
    bf16_t* O; int ldc; const float* qg; const float* kg; PG8_LAS float* part;
    __device__ __forceinline__ void operator()(const f32x4 (&acc)[2][2][4][2], const Unit& u, int wr, int wc, int fr, int fq) const {
        const bool normed = u.pn < 16, lo = fr < 8;
        f32x4 g[2][2];
#pragma unroll
        for (int bj = 0; bj < 2; ++bj)
#pragma unroll
            for (int n = 0; n < 2; ++n) g[bj][n] = (f32x4){1.f, 1.f, 1.f, 1.f};
        if (normed) {
            const float* gp = (u.pn < 8 ? qg : kg) + (wc & 1) * 64 + 8 * fq;
#pragma unroll
            for (int bj = 0; bj < 2; ++bj)
#pragma unroll
                for (int n = 0; n < 2; ++n) g[bj][n] = *(const f32x4*)(gp + bj * 32 + 4 * n);
#pragma unroll
            for (int ai = 0; ai < 2; ++ai)
#pragma unroll
                for (int m = 0; m < 4; ++m) { float ss = 0.f;
                    { const f32x4 a0 = acc[ai][0][m][0], a1 = acc[ai][0][m][1], b0 = acc[ai][1][m][0], b1 = acc[ai][1][m][1];
                      ss = (((a0[0] * a0[0] + a0[1] * a0[1]) + (a0[2] * a0[2] + a0[3] * a0[3])) + ((a1[0] * a1[0] + a1[1] * a1[1]) + (a1[2] * a1[2] + a1[3] * a1[3])))
                         + (((b0[0] * b0[0] + b0[1] * b0[1]) + (b0[2] * b0[2] + b0[3] * b0[3])) + ((b1[0] * b1[0] + b1[1] * b1[1]) + (b1[2] * b1[2] + b1[3] * b1[3]))); }
                    ss += __shfl_xor(ss, 16); ss += __shfl_xor(ss, 32);
                    if (fq == 0) part[(ai * HALF + wr * 64 + m * 16 + fr) * 4 + wc] = ss; }
            asm volatile("s_waitcnt lgkmcnt(0)" ::: "memory"); __builtin_amdgcn_s_barrier(); asm volatile("" ::: "memory");
        }
        bf16_t* base = O + (size_t)(u.pm * BM + wr * 64 + (fr & 7)) * ldc + u.pn * BM + wc * 64 + (lo ? 0 : 32) + 8 * fq;
#pragma unroll
        for (int ai = 0; ai < 2; ++ai)
#pragma unroll
            for (int m = 0; m < 4; ++m) {
                float rstd = 1.f;
                if (normed) { const PG8_LAS float* p = part + (ai * HALF + wr * 64 + m * 16 + fr) * 4 + (wc & 2); rstd = 1.0f / sqrtf((p[0] + p[1]) * (1.0f / 128.0f) + 1e-6f); }
                u32x4 w[2];
#pragma unroll
                for (int bj = 0; bj < 2; ++bj) { const f32x4 v0 = acc[ai][bj][m][0] * rstd * g[bj][0], v1 = acc[ai][bj][m][1] * rstd * g[bj][1];
                    w[bj].x = cvt_pk_bf16(v0[0], v0[1]); w[bj].y = cvt_pk_bf16(v0[2], v0[3]); w[bj].z = cvt_pk_bf16(v1[0], v1[1]); w[bj].w = cvt_pk_bf16(v1[2], v1[3]); }
                const u32x4 snd = lo ? w[1] : w[0];
                u32x4 rcv; rcv.x = __shfl_xor(snd.x, 8); rcv.y = __shfl_xor(snd.y, 8); rcv.z = __shfl_xor(snd.z, 8); rcv.w = __shfl_xor(snd.w, 8);
                bf16_t* rp = base + (size_t)(ai * HALF + m * 16) * ldc;
                *(u32x4*)rp = lo ? w[0] : rcv;
                *(u32x4*)(rp + (size_t)8 * ldc) = lo ? rcv : w[1];
                asm volatile("" ::: "memory");
            }
    }
};
struct EpiScalars {
    static constexpr bool PERM = false, AFTER_DRAIN = false;
    float* FLS; float* GG; float* GB; const float* f_bias; const float* a_log; const float* dt_bias; int seq, nh;
    __device__ __forceinline__ void operator()(const f32x4 (&acc)[2][2][4][2], const Unit& u, int wr, int wc, int fr, int fq) const {
        const bool diag = (((fr >> 2) ^ fq) & 1) == 0;
        const int e = fr & 3, ks = fr & 7;
        float mine[4] = {0.f, 0.f, 0.f, 0.f};
#pragma unroll
        for (int ai = 0; ai < 2; ++ai)
#pragma unroll
            for (int m = 0; m < 4; ++m)
#pragma unroll
                for (int bj = 0; bj < 2; ++bj)
#pragma unroll
                    for (int n = 0; n < 2; ++n) { const f32x4 a4 = acc[ai][bj][m][n];
                        float v = diag ? (e == 0 ? a4[0] : (e == 1 ? a4[1] : (e == 2 ? a4[2] : a4[3]))) : 0.f;
                        v += __shfl_xor(v, 1); v += __shfl_xor(v, 2); v += __shfl_xor(v, 20);
                        if (ks == ai * 4 + m) mine[bj * 2 + n] = v; }
        if (!diag) return;
        const int row = 32 * u.pm + 16 * (ks >> 2) + 8 * wr + 2 * (ks & 3) + (fr >> 3), b = row / seq, t = row % seq;
#pragma unroll
        for (int j = 0; j < 4; ++j) { const int col = 32 * u.pn + 16 * (j >> 1) + 4 * wc + 2 * (j & 1) + (fq >> 1);
            if (col < 48) { const int h = col & 15; const size_t o = (size_t)(b * nh + h) * seq + t; const float v = mine[j];
                if (col < 16) { const float z = v + f_bias[h]; FLS[o] = (z < 0.f ? z : 0.f) - log1pf(expf(-fabsf(z))); }
                else if (col < 32) { const float xs = v + dt_bias[h]; const float sp_ = xs > 20.f ? xs : log1pf(expf(xs)); GG[o] = -expf(a_log[h]) * sp_; }
                else GB[o] = 1.0f / (1.0f + expf(-v)); } }
    }
};
struct EpiProbe {
    static constexpr bool PERM = true, AFTER_DRAIN = false;
    float* sink;
    __device__ __forceinline__ void operator()(const f32x4 (&acc)[2][2][4][2], const Unit& u, int wr, int wc, int fr, int fq) const {
        f32x4 s = {0.f, 0.f, 0.f, 0.f};
#pragma unroll
        for (int ai = 0; ai < 2; ++ai)
#pragma unroll
            for (int bj = 0; bj < 2; ++bj)
#pragma unroll
                for (int m = 0; m < 4; ++m)
#pragma unroll
                    for (int n = 0; n < 2; ++n) s += acc[ai][bj][m][n];
        const float t = (s.x + s.y) + (s.z + s.w);
        if (t == 12345.678f) sink[u.pm * 64 + u.pn] = t;
    }
};

template <class E, class = void> struct badj_of { static constexpr bool v = false; };
template <class E> struct badj_of<E, decltype((void)E::BADJ)> { static constexpr bool v = E::BADJ; };
template <class Epi, class Sched, bool ALIGN_EPI = false, bool SP2 = false>
__device__ __forceinline__ void gemm_phase(PG8_LAS unsigned char* lds, const Gemm g, const Sched& S, const Epi& E) {
    int tid_ = threadIdx.x; asm volatile("" : "+v"(tid_));
    const int tid = tid_, wid = __builtin_amdgcn_readfirstlane(tid >> 6), lane = tid & 63, wr = wid >> 2, wc = wid & 3, fr = lane & 15, fq = lane >> 4;
    const int K = g.ld, nt = g.K / BK;
    unsigned voffA[2], voffB[2];
    constexpr bool BADJ = badj_of<Epi>::v;
#pragma unroll
    for (int i = 0; i < 2; ++i) { int R, C; stage_rc(tid * 16 + i * 8192, R, C); const int Rb = BADJ ? ((R >> 5) * 64 + perm32(R & 31)) : (Epi::PERM ? ((R & ~31) + perm32(R & 31)) : R);
        voffA[i] = (unsigned)(R * K + C) * 2u; voffB[i] = (unsigned)(Rb * K + C) * 2u; }
    const size_t kstep = (size_t)(BK * 2);
    const size_t hstep = (size_t)HALF * K * 2;
    const size_t hstepB = BADJ ? (size_t)32 * K * 2 : hstep;
    const size_t tstep = 2 * hstep;
    const unsigned ldsw = (unsigned)wid * 1024u;
    const int aoff = lds_byte(wr * 64 + fr, fq * 8), boff = lds_byte(wc * 32 + fr, fq * 8);
#define PG8_SA(b, h) (((b) * 2 + (h)) * HTB)
#define PG8_SB(b, h) ((4 + (b) * 2 + (h)) * HTB)
#define PG8_STAGE(bufoff, gbase, voff) do { _Pragma("unroll") for (int _i = 0; _i < 2; ++_i) \
        __builtin_amdgcn_global_load_lds((const unsigned*)((const char*)(gbase) + (voff)[_i]), (PG8_LAS unsigned*)(lds + (bufoff) + ldsw + _i * 8192), 16, 0, 0); } while (0)
#define PG8_LDA(dst, b, h) do { _Pragma("unroll") for (int m = 0; m < 4; ++m) _Pragma("unroll") for (int k = 0; k < 2; ++k) dst[m][k] = *(const PG8_LAS bf16x8*)(lds + PG8_SA(b, h) + aoff + m * 2048 + k * 1024); } while (0)
#define PG8_LDB(dst, b, h) do { _Pragma("unroll") for (int n = 0; n < 2; ++n) _Pragma("unroll") for (int k = 0; k < 2; ++k) dst[n][k] = *(const PG8_LAS bf16x8*)(lds + PG8_SB(b, h) + boff + n * 2048 + k * 1024); } while (0)
#define PG8_MMA(ai, bj, At, Bt) do { __builtin_amdgcn_s_setprio(1); _Pragma("unroll") for (int m = 0; m < 4; ++m) _Pragma("unroll") for (int n = 0; n < 2; ++n) _Pragma("unroll") for (int k = 0; k < 2; ++k) \
        acc[ai][bj][m][n] = __builtin_amdgcn_mfma_f32_16x16x32_bf16(Bt[n][k], At[m][k], acc[ai][bj][m][n], 0, 0, 0); __builtin_amdgcn_s_setprio(0); } while (0)
#define PG8_WAIT_V(n) asm volatile("s_waitcnt vmcnt(" #n ")" ::: "memory")
#define PG8_WAIT_L(n) asm volatile("s_waitcnt lgkmcnt(" #n ")" ::: "memory")
#define PG8_BAR __builtin_amdgcn_s_barrier()
#define PG8_SCHED __builtin_amdgcn_sched_barrier(0)
    Unit cur, nxt; int ui = 0;
    if (!S.next(0, cur)) return;
    f32x4 acc[2][2][4][2];
#pragma unroll
    for (int a = 0; a < 2; ++a)
#pragma unroll
        for (int b = 0; b < 2; ++b)
#pragma unroll
            for (int m = 0; m < 4; ++m)
#pragma unroll
                for (int n = 0; n < 2; ++n) acc[a][b][m][n] = (f32x4){0.f, 0.f, 0.f, 0.f};
    bf16x8 At[4][2], B0[2][2], B1[2][2];
    const char* cA = (const char*)g.A + (size_t)cur.pm * tstep; const char* cB = (const char*)g.Bt + (size_t)cur.pn * tstep;
    S.a_ready(cur);
    if constexpr (SP2) {
        PG8_STAGE(PG8_SB(0, 0), cB, voffB); PG8_STAGE(PG8_SB(0, 1), cB + hstepB, voffB); PG8_STAGE(PG8_SA(0, 0), cA, voffA); PG8_STAGE(PG8_SA(0, 1), cA + hstep, voffA);
        if (wr == 1) PG8_BAR;
        PG8_WAIT_V(2); PG8_BAR;
        PG8_STAGE(PG8_SB(1, 0), cB + kstep, voffB); PG8_STAGE(PG8_SA(1, 0), cA + kstep, voffA); PG8_STAGE(PG8_SB(1, 1), cB + hstepB + kstep, voffB);
        PG8_WAIT_V(6); PG8_BAR;
    } else {
        PG8_STAGE(PG8_SB(0, 0), cB, voffB); PG8_STAGE(PG8_SA(0, 0), cA, voffA); PG8_STAGE(PG8_SB(0, 1), cB + hstepB, voffB); PG8_STAGE(PG8_SA(0, 1), cA + hstep, voffA);
        if (wr == 1) PG8_BAR;
        PG8_WAIT_V(4); PG8_BAR;
        PG8_STAGE(PG8_SB(1, 0), cB + kstep, voffB); PG8_STAGE(PG8_SA(1, 0), cA + kstep, voffA); PG8_STAGE(PG8_SB(1, 1), cB + hstepB + kstep, voffB);
        PG8_WAIT_V(6); PG8_BAR;
    }
    for (;;) {
        const bool has_next = S.next(ui + 1, nxt);
        const char* nA = has_next ? (const char*)g.A + (size_t)nxt.pm * tstep : cA; const char* nB = has_next ? (const char*)g.Bt + (size_t)nxt.pn * tstep : cB;
        for (int t = 0; t < nt; t += 2) {
            const bool last = (t == nt - 2);
            const char* a1 = cA + (size_t)(t + 1) * kstep;
            const char* a2 = last ? nA : cA + (size_t)(t + 2) * kstep; const char* b2 = last ? nB : cB + (size_t)(t + 2) * kstep;
            const char* a3 = a2 + kstep; const char* b3 = b2 + kstep;
            if (last && has_next) S.a_ready(nxt);
            if constexpr (SP2) {
            PG8_LDB(B0, 0, 0); PG8_LDB(B1, 0, 1); PG8_SCHED; PG8_LDA(At, 0, 0); PG8_STAGE(PG8_SA(1, 1), a1 + hstep, voffA);
            PG8_WAIT_V(8); PG8_WAIT_L(0); PG8_BAR; PG8_MMA(0, 0, At, B0); PG8_MMA(0, 1, At, B1); PG8_BAR; PG8_SCHED;
            PG8_LDA(At, 0, 1); PG8_STAGE(PG8_SB(0, 0), b2, voffB); PG8_STAGE(PG8_SB(0, 1), b2 + hstepB, voffB); PG8_STAGE(PG8_SA(0, 0), a2, voffA);
            PG8_WAIT_V(8); PG8_WAIT_L(0); PG8_BAR; PG8_MMA(1, 0, At, B0); PG8_MMA(1, 1, At, B1); PG8_BAR; PG8_SCHED;
            PG8_LDB(B0, 1, 0); PG8_LDB(B1, 1, 1); PG8_SCHED; PG8_LDA(At, 1, 0); PG8_STAGE(PG8_SA(0, 1), a2 + hstep, voffA);
            PG8_WAIT_V(8); PG8_WAIT_L(0); PG8_BAR; PG8_MMA(0, 0, At, B0); PG8_MMA(0, 1, At, B1); PG8_BAR; PG8_SCHED;
            PG8_LDA(At, 1, 1); PG8_STAGE(PG8_SB(1, 0), b3, voffB); PG8_STAGE(PG8_SB(1, 1), b3 + hstepB, voffB); PG8_STAGE(PG8_SA(1, 0), a3, voffA);
            PG8_WAIT_V(8); PG8_WAIT_L(0); PG8_BAR; PG8_MMA(1, 0, At, B0); PG8_MMA(1, 1, At, B1); PG8_BAR; PG8_SCHED;
            } else {
            PG8_LDB(B0, 0, 0); PG8_SCHED; PG8_LDA(At, 0, 0); PG8_STAGE(PG8_SA(1, 1), a1 + hstep, voffA);
            PG8_WAIT_L(8); PG8_BAR; PG8_WAIT_L(0); PG8_MMA(0, 0, At, B0); PG8_BAR; PG8_SCHED;
            PG8_LDB(B1, 0, 1); PG8_STAGE(PG8_SB(0, 0), b2, voffB);
            PG8_BAR; PG8_WAIT_L(0); PG8_MMA(0, 1, At, B1); PG8_BAR;
            PG8_LDA(At, 0, 1); PG8_STAGE(PG8_SA(0, 0), a2, voffA);
            PG8_BAR; PG8_WAIT_L(0); PG8_MMA(1, 0, At, B0); PG8_BAR; PG8_SCHED;
            PG8_STAGE(PG8_SB(0, 1), b2 + hstepB, voffB);
            PG8_WAIT_V(6); PG8_BAR; PG8_MMA(1, 1, At, B1); PG8_BAR;
            PG8_LDB(B0, 1, 0); PG8_SCHED; PG8_LDA(At, 1, 0); PG8_STAGE(PG8_SA(0, 1), a2 + hstep, voffA);
            PG8_WAIT_L(8); PG8_BAR; PG8_WAIT_L(0); PG8_MMA(0, 0, At, B0); PG8_BAR; PG8_SCHED;
            PG8_LDB(B1, 1, 1); PG8_STAGE(PG8_SB(1, 0), b3, voffB);
            PG8_BAR; PG8_WAIT_L(0); PG8_MMA(0, 1, At, B1); PG8_BAR;
            PG8_LDA(At, 1, 1); PG8_STAGE(PG8_SA(1, 0), a3, voffA);
            PG8_BAR; PG8_WAIT_L(0); PG8_MMA(1, 0, At, B0); PG8_BAR; PG8_SCHED;
            PG8_STAGE(PG8_SB(1, 1), b3 + hstepB, voffB);
            PG8_WAIT_V(6); PG8_BAR; PG8_MMA(1, 1, At, B1); PG8_BAR;
            }
        }
        if constexpr (ALIGN_EPI) { if (wr == 0) PG8_BAR; }
        if constexpr (!Epi::AFTER_DRAIN) { E(acc, cur, wr, wc, fr, fq); S.done(cur); }
        if (!has_next) break;
#pragma unroll
        for (int a = 0; a < 2; ++a)
#pragma unroll
            for (int b = 0; b < 2; ++b)
#pragma unroll
                for (int m = 0; m < 4; ++m)
#pragma unroll
                    for (int n = 0; n < 2; ++n) acc[a][b][m][n] = (f32x4){0.f, 0.f, 0.f, 0.f};
        cur = nxt; cA = nA; cB = nB; ++ui;
        if constexpr (ALIGN_EPI) { if (wr == 1) PG8_BAR; }
    }
    PG8_WAIT_V(0);
    if constexpr (!ALIGN_EPI) { if (wr == 0) PG8_BAR; }
    PG8_BAR;
    if constexpr (Epi::AFTER_DRAIN) { E.fused(acc, cur, wr, wc, fr, fq, lds, wid, lane); S.done(cur); }
#undef PG8_SA
#undef PG8_SB
#undef PG8_STAGE
#undef PG8_LDA
#undef PG8_LDB
#undef PG8_MMA
#undef PG8_WAIT_V
#undef PG8_WAIT_L
#undef PG8_BAR
#undef PG8_SCHED
}
}
namespace fox {
typedef unsigned short bf16;
typedef short bf16x8 __attribute__((ext_vector_type(8)));
typedef short s16x4 __attribute__((ext_vector_type(4)));
typedef float f32x16 __attribute__((ext_vector_type(16)));
typedef float f32x4 __attribute__((ext_vector_type(4)));
typedef unsigned u32x4 __attribute__((ext_vector_type(4)));
constexpr int D = 128, NW = 8, QBLK = 32, KVBLK = 64, QB = NW * QBLK;
constexpr int SHM_V = KVBLK * D * 2, SHM_K = KVBLK * D * 2;
constexpr int LDS_WS = 2 * SHM_V + 2 * SHM_K, LDS_KX = LDS_WS + NW * 64 * 4, LDS_Q = LDS_KX + 2 * 1024, LDS_BYTES = LDS_Q + NW * QBLK * D * 2;
constexpr float SCALE = 0.08838834764831845f;
constexpr float C2 = 1.4426950408889634f * SCALE;
constexpr float THR = 8.f;

#define KSWZ(row, colB) ((row) * 256 + ((colB) ^ (((row) & 7) << 4)))
#define SBAR() __builtin_amdgcn_sched_barrier(0)
__device__ __forceinline__ int v_st(int k, int c) { const int kk = (k & ~0xC) | ((k & 4) << 1) | ((k & 8) >> 1); return ((kk >> 3) * 4 + (c >> 5)) * 512 + ((kk & 7) * 32 + (c & 31)) * 2; }
__device__ __forceinline__ int v_rd_base(int lane) { return ((lane & 3) << 3) | (((lane >> 2) & 3) << 6) | (((lane >> 4) & 1) << 5) | (((lane >> 5) & 1) << 8); }
constexpr int v_rd_off(int d0, int ks, int half) { return d0 * 512 + ks * 4096 + half * 2048; }
__device__ __forceinline__ int crow(int r, int hi) { return (r & 3) + 8 * (r >> 2) + 4 * hi; }
__device__ __forceinline__ unsigned cvtpk(float lo, float hi) { unsigned r; asm volatile("v_cvt_pk_bf16_f32 %0, %1, %2" : "=v"(r) : "v"(lo), "v"(hi)); return r; }
__device__ __forceinline__ bf16x8 load8(const bf16* p) { return *reinterpret_cast<const bf16x8*>(p); }
__device__ __forceinline__ void mask_tile(f32x16& p0, f32x16& p1, int dq) {
    const float NEG = -__builtin_inff();
#pragma unroll
    for (int r = 0; r < 16; ++r) {
        const int c = (r & 3) + 8 * (r >> 2);
        if (dq - c < 0) p0[r] = NEG;
        if (dq - c - 32 < 0) p1[r] = NEG;
    }
}
__device__ __forceinline__ void partialSM(f32x16& p0, f32x16& p1, float& m_reg, float& mn, float& alpha) {
    float pmax = p0[0];
#pragma unroll
    for (int r = 1; r < 16; ++r) pmax = fmaxf(pmax, p0[r]);
#pragma unroll
    for (int r = 0; r < 16; ++r) pmax = fmaxf(pmax, p1[r]);
    { auto rr = __builtin_amdgcn_permlane32_swap(__float_as_uint(pmax), __float_as_uint(pmax), false, false);
      pmax = fmaxf(__uint_as_float(rr[0]), __uint_as_float(rr[1])); }
    if (__builtin_expect(__all((pmax - m_reg) * SCALE <= THR), 1)) { mn = m_reg; alpha = 1.f; }
    else { mn = fmaxf(m_reg, pmax); alpha = __builtin_amdgcn_exp2f((m_reg - mn) * C2); m_reg = mn; }
    const float mnL = -mn * C2;
#pragma unroll
    for (int r = 0; r < 16; ++r) p0[r] = fmaf(p0[r], C2, mnL);
#pragma unroll
    for (int r = 0; r < 16; ++r) p1[r] = fmaf(p1[r], C2, mnL);
#pragma unroll
    for (int r = 0; r < 16; ++r) p0[r] = __builtin_amdgcn_exp2f(p0[r]);
}
__device__ __forceinline__ void finishSM(f32x16& p0, f32x16& p1, float alpha, float& l_reg, bf16x8& pa0, bf16x8& pa1, bf16x8& pa2, bf16x8& pa3) {
#pragma unroll
    for (int r = 0; r < 16; ++r) p1[r] = __builtin_amdgcn_exp2f(p1[r]);
    float ps = 0;
#pragma unroll
    for (int r = 0; r < 16; ++r) ps += p0[r];
#pragma unroll
    for (int r = 0; r < 16; ++r) ps += p1[r];
    { auto rr = __builtin_amdgcn_permlane32_swap(__float_as_uint(ps), __float_as_uint(ps), false, false);
      ps = __uint_as_float(rr[0]) + __uint_as_float(rr[1]); }
    l_reg = l_reg * alpha + ps;
#define PK4(P, B_, OUT) do { unsigned a0 = cvtpk(P[B_+0], P[B_+1]), a1 = cvtpk(P[B_+2], P[B_+3]);                          \
        unsigned b0 = cvtpk(P[B_+4], P[B_+5]), b1 = cvtpk(P[B_+6], P[B_+7]);                                             \
        auto r0 = __builtin_amdgcn_permlane32_swap(a0, b0, false, false); auto r1 = __builtin_amdgcn_permlane32_swap(a1, b1, false, false); \
        u32x4 w = {r0[0], r1[0], r0[1], r1[1]}; OUT = *reinterpret_cast<bf16x8*>(&w); } while (0)
    PK4(p0, 0, pa0); PK4(p0, 8, pa1); PK4(p1, 0, pa2); PK4(p1, 8, pa3);
#undef PK4
}
template <int KB>
__device__ __forceinline__ void qkt(f32x16& p0, f32x16& p1, const char* K_lds, const char* KX_lds, int r32, int hi, const char* Qw) {
    p0 = f32x16{}; p1 = f32x16{};
    {
        const short one = hi ? (short)0 : (short)0x3F80;
        const bf16x8 qx = {one, one, one, 0, 0, 0, 0, 0};
        const bf16x8 x0 = *reinterpret_cast<const bf16x8*>(KX_lds + KB * 1024 + r32 * 16);
        const bf16x8 x1 = *reinterpret_cast<const bf16x8*>(KX_lds + KB * 1024 + (32 + r32) * 16);
        p0 = __builtin_amdgcn_mfma_f32_32x32x16_bf16(x0, qx, p0, 0, 0, 0);
        p1 = __builtin_amdgcn_mfma_f32_32x32x16_bf16(x1, qx, p1, 0, 0, 0); }
    const char* kb[4]; const char* qb[4];
#pragma unroll
    for (int dd = 0; dd < 4; ++dd) { const int sw = KSWZ(r32, (dd * 16 + hi * 8) * 2); kb[dd] = K_lds + KB * SHM_K + sw; qb[dd] = Qw + sw; }
#pragma unroll
    for (int d0 = 0; d0 < 8; ++d0) { const char* a = kb[d0 & 3] + (d0 >> 2) * 128;
        bf16x8 b0 = *reinterpret_cast<const bf16x8*>(a);
        bf16x8 b1 = *reinterpret_cast<const bf16x8*>(a + 32 * 256);
        bf16x8 q = *reinterpret_cast<const bf16x8*>(qb[d0 & 3] + (d0 >> 2) * 128);
        p0 = __builtin_amdgcn_mfma_f32_32x32x16_bf16(b0, q, p0, 0, 0, 0);
        p1 = __builtin_amdgcn_mfma_f32_32x32x16_bf16(b1, q, p1, 0, 0, 0); }
}
template <int VB>
__device__ __forceinline__ void pv_tile(f32x16* o, int vb0, bf16x8 pa0, bf16x8 pa1, bf16x8 pa2, bf16x8 pa3) {
#define TRRD(dst, off) asm volatile("ds_read_b64_tr_b16 %0, %1 offset:%2" : "=&v"(dst) : "v"(vb0), "i"(off) : "memory")
#define PV_D0(d0) do { s16x4 l0, l1, l2, l3, h0, h1, h2, h3; constexpr int b_ = VB * SHM_V + v_rd_off(d0, 0, 0); \
        TRRD(l0, b_); TRRD(h0, b_ + 2048); TRRD(l1, b_ + 4096); TRRD(h1, b_ + 6144); TRRD(l2, b_ + 8192); TRRD(h2, b_ + 10240); TRRD(l3, b_ + 12288); TRRD(h3, b_ + 14336); \
        asm volatile("s_waitcnt lgkmcnt(0)" ::: "memory"); SBAR();   \
        o[d0] = __builtin_amdgcn_mfma_f32_32x32x16_bf16(pa0, (bf16x8){l0[0], l0[1], l0[2], l0[3], h0[0], h0[1], h0[2], h0[3]}, o[d0], 0, 0, 0);   \
        o[d0] = __builtin_amdgcn_mfma_f32_32x32x16_bf16(pa1, (bf16x8){l1[0], l1[1], l1[2], l1[3], h1[0], h1[1], h1[2], h1[3]}, o[d0], 0, 0, 0);   \
        o[d0] = __builtin_amdgcn_mfma_f32_32x32x16_bf16(pa2, (bf16x8){l2[0], l2[1], l2[2], l2[3], h2[0], h2[1], h2[2], h2[3]}, o[d0], 0, 0, 0);   \
        o[d0] = __builtin_amdgcn_mfma_f32_32x32x16_bf16(pa3, (bf16x8){l3[0], l3[1], l3[2], l3[3], h3[0], h3[1], h3[2], h3[3]}, o[d0], 0, 0, 0); } while (0)
    PV_D0(0); PV_D0(1); PV_D0(2); PV_D0(3);
#undef PV_D0
#undef TRRD
}

struct BlockRef { unsigned q, k, v, kx, o; int P0; };
struct Bases { const bf16* P; const bf16* KX; bf16* O; };
struct Seam { bf16x8 st_v0, st_v1, st_k0, st_k1; };
#define ROW(p, k0, rr) ((p) + (size_t)(k0) * PQ + (unsigned)((rr) * PQ + sc))
#define VMW() asm volatile("s_waitcnt vmcnt(0)" ::: "memory")
#define VMWN(n) asm volatile("s_waitcnt vmcnt(%0)" :: "i"(n) : "memory")
#define SLOAD_H(Kp, Vp, KXp, k0, kxb) do { S.st_v0 = load8(ROW(Vp, k0, sr)); S.st_v1 = load8(ROW(Vp, k0, 32 + sr));              \
                         S.st_k0 = load8(ROW(Kp, k0, sr)); S.st_k1 = load8(ROW(Kp, k0, 32 + sr));                                 \
                         if (wid == 0) __builtin_amdgcn_global_load_lds((const unsigned*)((KXp) + (size_t)(k0) * 8 + (unsigned)(lane * 8)), (__attribute__((address_space(3))) unsigned*)(KX_lds + (kxb) * 1024), 16, 0, 0); } while (0)
#define SWRITE_HK(bf) do { *(bf16x8*)(K_lds + (bf) * SHM_K + kws) = S.st_k0; *(bf16x8*)(K_lds + (bf) * SHM_K + kws + 32 * 256) = S.st_k1; } while (0)
#define SWRITE_HV(bf) do { *(bf16x8*)(V_lds + (bf) * SHM_V + vst0) = S.st_v0; *(bf16x8*)(V_lds + (bf) * SHM_V + vst1) = S.st_v1; } while (0)
#define SWRITE_H(bf) do { SWRITE_HV(bf); SWRITE_HK(bf); } while (0)
#define QLOAD(qoff) do { _Pragma("unroll") for (int i_ = 0; i_ < 8; ++i_) { const int row_ = 4 * i_ + (lane >> 4);                                             \
        __builtin_amdgcn_global_load_lds((const unsigned*)(Bs.P + (qoff) + (size_t)(wid * QBLK + 4 * i_) * PQ + (unsigned)((lane >> 4) * PQ + (((lane & 15) ^ (row_ & 7)) * 8))), \
                                         (__attribute__((address_space(3))) unsigned*)(Qw + i_ * 1024), 16, 0, 0); } } while (0)
template <int PQ, int PO>
__device__ __forceinline__ void fox_prime(const Bases& Bs, const BlockRef& cur, char* lds, Seam& S) {
    const int tid = threadIdx.x, wid = __builtin_amdgcn_readfirstlane(tid >> 6), lane = tid & 63, r32 = lane & 31, hi = lane >> 5;
    const int sr = tid >> 4, sc = (tid & 15) * 8, kws = KSWZ(sr, sc * 2); char* K_lds = lds + 2 * SHM_V; char* KX_lds = lds + LDS_KX; char* Qw = lds + LDS_Q + wid * (QBLK * D * 2);
    QLOAD(cur.q);
    SLOAD_H(Bs.P + cur.k, Bs.P + cur.v, Bs.KX + (size_t)cur.kx * 8, 0, 0); VMW(); SWRITE_HK(0);
    __syncthreads();
}
template <int PQ, int PO>
__device__ __forceinline__ void fox_block(const Bases& Bs, const BlockRef& cur, const BlockRef& nxt, char* lds, Seam& S) {
    const int tid = threadIdx.x, wid = __builtin_amdgcn_readfirstlane(tid >> 6), lane = tid & 63, r32 = lane & 31, hi = lane >> 5;
    const int NT = (cur.P0 + QB - 1) / KVBLK + 1;
    const int qlo = cur.P0 + wid * QBLK, qm = qlo + r32 - 4 * hi;
    char* V_lds = lds; char* K_lds = lds + 2 * SHM_V;
    float* ws = (float*)(lds + LDS_WS) + wid * 64; float* li_l = ws, * al_l = ws + 32; char* KX_lds = lds + LDS_KX; char* Qw = lds + LDS_Q + wid * (QBLK * D * 2);
    float m_reg = -1e30f, l_reg = 0; f32x16 o[4] = {};
    const int sr = tid >> 4, sc = (tid & 15) * 8, vst0 = v_st(sr, sc), vst1 = v_st(32 + sr, sc), kws = KSWZ(sr, sc * 2);
    const int vb0 = (int)(uintptr_t)V_lds + v_rd_base(lane);
    const bf16* Kh = Bs.P + cur.k; const bf16* Vh = Bs.P + cur.v; const bf16* KXh = Bs.KX + (size_t)cur.kx * 8;
#define RESC(a) do { if (__any((a) < 1.f)) { if (hi == 0) al_l[r32] = (a); asm volatile("s_waitcnt lgkmcnt(0)" ::: "memory");              \
                     for (int d_ = 0; d_ < 4; ++d_) for (int r = 0; r < 16; ++r) o[d_][r] *= al_l[crow(r, hi)]; } } while (0)
#define KBASE(t) ((t) * KVBLK)
#define MASKT(P0_, P1_, t) do { const int kb_ = KBASE(t); if (kb_ + KVBLK - 1 > qlo) mask_tile(P0_, P1_, qm - kb_); } while (0)
    constexpr int NQL = 8;
#define SEAM_K0() do { VMWN(NQL); SWRITE_HK(0); SBAR(); } while (0)
    f32x16 pA0, pA1, pB0, pB1; float mnA, mnB, alA, alB; bf16x8 pa0, pa1, pa2, pa3;
    SWRITE_HV(0); SBAR();
    if (NT > 1) SLOAD_H(Kh, Vh, KXh, KBASE(1), 1);
    SBAR(); qkt<0>(pA0, pA1, K_lds, KX_lds, r32, hi, Qw);
    MASKT(pA0, pA1, 0); partialSM(pA0, pA1, m_reg, mnA, alA);
    if (NT > 1) { VMW(); SWRITE_H(1); }
    __syncthreads();
#define HALF_STEP(PX0, PX1, mnX, alX, PY0, PY1, alY, t, KB, VB, SB) do {                                                      \
        SBAR(); qkt<KB>(PX0, PX1, K_lds, KX_lds, r32, hi, Qw);                                                                    \
        finishSM(PY0, PY1, alY, l_reg, pa0, pa1, pa2, pa3); SBAR();                                                           \
        if ((t) + 1 < NT) { SLOAD_H(Kh, Vh, KXh, KBASE((t) + 1), SB); SBAR(); }                                                 \
        pv_tile<VB>(o, vb0, pa0, pa1, pa2, pa3); MASKT(PX0, PX1, (t)); partialSM(PX0, PX1, m_reg, mnX, alX); \
        __syncthreads();                                                                                                      \
        if ((t) + 1 < NT) { VMW(); SWRITE_H(SB); }                                                                            \
        RESC(alX); __syncthreads(); } while (0)
    for (int t = 1; t + 1 < NT; t += 2) {
        HALF_STEP(pB0, pB1, mnB, alB, pA0, pA1, alA, t, 1, 0, 0);
        HALF_STEP(pA0, pA1, mnA, alA, pB0, pB1, alB, t + 1, 0, 1, 1);
    }
    const bool even = (NT & 1) == 0;
    if (even) { SBAR(); qkt<1>(pB0, pB1, K_lds, KX_lds, r32, hi, Qw); SBAR(); }
    SLOAD_H(Bs.P + nxt.k, Bs.P + nxt.v, Bs.KX + (size_t)nxt.kx * 8, 0, 0); SBAR();
    QLOAD(nxt.q);
    SBAR();
    finishSM(pA0, pA1, alA, l_reg, pa0, pa1, pa2, pa3); SBAR();
    pv_tile<0>(o, vb0, pa0, pa1, pa2, pa3);
    if (even) { MASKT(pB0, pB1, NT - 1); partialSM(pB0, pB1, m_reg, mnB, alB); __syncthreads(); RESC(alB);
        finishSM(pB0, pB1, alB, l_reg, pa0, pa1, pa2, pa3); SBAR(); pv_tile<1>(o, vb0, pa0, pa1, pa2, pa3); }
    SBAR(); SEAM_K0();
    if (hi == 0) li_l[r32] = l_reg; asm volatile("s_waitcnt lgkmcnt(0)" ::: "memory");
    float rli[16];
#pragma unroll
    for (int r = 0; r < 16; ++r) rli[r] = __builtin_amdgcn_rcpf(li_l[crow(r, hi)]);
    bf16* Ow = Bs.O + cur.o + (size_t)(wid * QBLK) * PO;
#pragma unroll
    for (int r = 0; r < 16; ++r) { const int orow = crow(r, hi);
#pragma unroll
        for (int d0 = 0; d0 < 4; ++d0) { const float v = o[d0][r] * rli[r];
            const float vn = __shfl_xor(v, 1);
            if ((r32 & 1) == 0) *(unsigned*)(Ow + (unsigned)(orow * PO + d0 * 32 + r32)) = cvtpk(v, vn); } }
    __syncthreads();
#undef RESC
#undef KBASE
#undef MASKT
#undef SEAM_K0
#undef HALF_STEP
}
#undef ROW
#undef VMW
#undef VMWN
#undef SLOAD_H
#undef SWRITE_HK
#undef SWRITE_HV
#undef SWRITE_H
#undef SBAR
#undef KSWZ
}
#ifndef PG8_SP2
#define PG8_SP2 true
#endif
#ifndef PG8_ALIGN
#define PG8_ALIGN true
#endif
constexpr int NWAVES = 8;
#ifndef MK_ONE_LAUNCH
#define MK_ONE_LAUNCH 1
#endif
constexpr int N_PHASES = 12;

constexpr int BATCH = 2, SEQ = 4096, DM = 4096, M = BATCH * SEQ;
constexpr int HD = 128, NH = 16;
constexpr int FOXW = 2048, GDNW = 2048, FF = 11008, NMOD = 6 * DM;
constexpr int IN_COLS = 14384;
constexpr int NP = 14336;
constexpr int NPP = 14400;
constexpr int NPT = 14400;
constexpr float EPS = 1e-6f;
constexpr int PC_Q = 0, PC_K = 2048, PC_V = 4096, PC_G = 6144, PC_Z = 12288, PC_F = 14336, PC_A = 14352, PC_B = 14368;
constexpr int SRC_F = 6144, SRC_G = 6160, SRC_A = 12304, SRC_B = 12320, SRC_Z = 12336;
constexpr int ADA_KS = 64, ADA_NT = ADA_KS * (NMOD / 256);

constexpr size_t MiB = 1u << 20;
constexpr size_t WS_CTL = 0, CTL_ZERO_BYTES = 65536;
constexpr size_t WS_MOD   = 1 * MiB;
constexpr size_t WS_KX    = 5 * MiB;
constexpr size_t WS_FLS   = 2 * MiB;
constexpr size_t WS_GG    = 3 * MiB;
constexpr size_t WS_GB    = 4 * MiB;
constexpr size_t WS_MODP  = 8 * MiB;
constexpr int LDK = 4224;
constexpr int LDMIX = DM, LDWOUT = DM;
constexpr int LDH = DM, LDWIN = DM;
constexpr int LDH2 = LDK, LDWGU = LDK;
constexpr size_t WS_WIN   = 32 * MiB;
constexpr size_t WS_WOUT  = 152 * MiB;
constexpr size_t WS_WGU   = 188 * MiB;
constexpr size_t WS_WD    = 368 * MiB;
constexpr size_t WS_H     = 456 * MiB;
constexpr size_t WS_MIX   = 524 * MiB;
constexpr size_t WS_P     = 592 * MiB;
constexpr size_t WS_HID   = 592 * MiB;
constexpr size_t WS_GO    = 820 * MiB;
constexpr size_t WS_SP    = WS_GO;
constexpr size_t WS_CH    = 884 * MiB;
constexpr size_t WS_X1    = WS_CH;
constexpr size_t WS_UC    = 1004 * MiB;
constexpr size_t WS_GT    = 7 * MiB;
constexpr size_t WS_END   = 1068 * MiB;
static_assert(WS_WIN + (size_t)NPT * LDWIN * 2 <= WS_WOUT && WS_WOUT + (size_t)DM * LDWOUT * 2 <= WS_WGU && WS_WGU + (size_t)2 * FF * LDWGU * 2 <= WS_WD && WS_WD + (size_t)DM * FF * 2 <= WS_H &&
              WS_H + (size_t)M * LDH2 * 2 <= WS_MIX && LDH2 >= LDH && WS_MIX + (size_t)M * LDMIX * 2 <= WS_P && WS_P + (size_t)M * NPP * 2 <= WS_GO, "d_ws map");
constexpr int CH_W = 0, CH_Q = 16896, CH_KT = 33792, CH_AQ = 51200, CH_BYTES = 61440;
constexpr int RS_W = 264, RS_K = 136;
constexpr int NCHUNK = BATCH * NH * (SEQ / 64);
constexpr int CW_BAR = 4096, CW_QUEUE = 8192;

constexpr int RING_OFF = 0, RING_BYTES = 131072;
constexpr int PHASE_LDS = 143360;
constexpr int LDSCTL_OFF = PHASE_LDS, MISC_OFF = LDSCTL_OFF + 320;
constexpr int LDS_BYTES = 147456;
static_assert(MISC_OFF + 128 <= LDS_BYTES && fox::LDS_BYTES <= PHASE_LDS, "LDS map");

#define GAS __attribute__((address_space(1)))
#define LAS __attribute__((address_space(3)))
typedef unsigned short bf16;
typedef unsigned v4u __attribute__((ext_vector_type(4)));
typedef unsigned v2u __attribute__((ext_vector_type(2)));
typedef float f32x4 __attribute__((ext_vector_type(4)));
typedef GAS unsigned gu32;
#define RLX_AGENT __ATOMIC_RELAXED, __HIP_MEMORY_SCOPE_AGENT
#define LDS_WAIT() asm volatile("s_waitcnt lgkmcnt(0)" ::: "memory")
#define VM_WAIT() asm volatile("s_waitcnt vmcnt(0)" ::: "memory")
__device__ __forceinline__ unsigned f2bf(float f) { unsigned u = __builtin_bit_cast(unsigned, f); return (u + 0x7fffu + ((u >> 16) & 1u)) >> 16; }
typedef float pkf32x2 __attribute__((ext_vector_type(2))); typedef __bf16 pkbf16x2 __attribute__((ext_vector_type(2)));
__device__ __forceinline__ unsigned pk2(float lo, float hi) { pkf32x2 v = {lo, hi}; pkbf16x2 b = __builtin_convertvector(v, pkbf16x2); return __builtin_bit_cast(unsigned, b); }
__device__ __forceinline__ float bf2f(unsigned short h) { return __builtin_bit_cast(float, (unsigned)h << 16); }
__device__ __forceinline__ float bflo(unsigned w) { return __builtin_bit_cast(float, w << 16); }
__device__ __forceinline__ float bfhi(unsigned w) { return __builtin_bit_cast(float, w & 0xffff0000u); }
__device__ __forceinline__ float sigmoidf_(float x) { return 1.0f / (1.0f + __expf(-x)); }
__device__ __forceinline__ float siluf_(float x) { return x * __builtin_amdgcn_rcpf(1.0f + __builtin_amdgcn_exp2f(-1.4426950408889634f * x)); }

#define XB_TMO      128
#define XB_XCNT(j)  (256  + 64 * (j))
#define XB_XSUB(j)  (1280 + 64 * (j))
#define XB_XGEN(j)  (2304 + 64 * (j))
#define XB_TOP      3328
#define XB_TOPGEN   3392
#define XCD_BAR_WORDS 3456
#define XB_SPIN_CAP (1u << 18)

__device__ __forceinline__ unsigned xb_ld(unsigned* p)              { return __hip_atomic_load(p, __ATOMIC_RELAXED, __HIP_MEMORY_SCOPE_AGENT); }
__device__ __forceinline__ unsigned xb_add(unsigned* p, unsigned v) { return __hip_atomic_fetch_add(p, v, __ATOMIC_RELAXED, __HIP_MEMORY_SCOPE_AGENT); }
__device__ __forceinline__ unsigned xb_xcc_id() { return (unsigned)__builtin_amdgcn_s_getreg((3 << 11) | 20) & 0xFu; }
#define XB_SPIN(cond, bar) do { unsigned _sp = 0; while (cond) { __builtin_amdgcn_s_sleep(1); \
    if ((++_sp & 255u) == 0u) { if (xb_ld(&(bar)[XB_TMO])) break; if (_sp > XB_SPIN_CAP) { atomicAdd(&(bar)[XB_TMO], 1u); break; } } } } while (0)

struct XcdBarrier {
    unsigned* bar; unsigned x;
    volatile LAS unsigned* st;
};

__device__ __forceinline__ XcdBarrier xcd_barrier_post(unsigned* bar, volatile LAS unsigned* st) {
    XcdBarrier b; b.bar = bar; b.x = xb_xcc_id(); b.st = st;
    if (threadIdx.x == 0) (void)xb_add(&bar[XB_XCNT(b.x)], 1u);
    return b;
}
__device__ __forceinline__ void xcd_barrier_complete(unsigned* bar, unsigned x, unsigned& nloc, unsigned& nx) {
    const unsigned G = gridDim.x * gridDim.y * gridDim.z;
    unsigned sum, cnt, mine, sp = 0u;
    for (;;) {
        sum = 0u; cnt = 0u; mine = 0u;
#pragma unroll
        for (unsigned j = 0; j < 16; ++j) { const unsigned c = xb_ld(&bar[XB_XCNT(j)]); sum += c; cnt += (c > 0u) ? 1u : 0u; mine = (j == x) ? c : mine; }
        if (sum == G) break;
        __builtin_amdgcn_s_sleep(1);
        if ((++sp & 255u) == 0u) { if (xb_ld(&bar[XB_TMO])) break; if (sp > XB_SPIN_CAP) { atomicAdd(&bar[XB_TMO], 1u); break; } }
    }
    nloc = mine > 0u ? mine : 1u; nx = cnt > 0u ? cnt : 1u;
}

__device__ __forceinline__ void xcd_barrier(const XcdBarrier& b) {
    asm volatile("s_waitcnt vmcnt(0)" ::: "memory");
    __syncthreads();
    if (threadIdx.x == 0) {
        unsigned* bar = b.bar;
        __builtin_amdgcn_s_waitcnt(0);
        unsigned nloc = b.st[0], nx = b.st[1];
        if (nloc == 0u) { xcd_barrier_complete(bar, b.x, nloc, nx); b.st[0] = nloc; b.st[1] = nx; }
        const unsigned old = xb_add(&bar[XB_XSUB(b.x)], 1u);
        const unsigned gen = old / nloc;
        if (old + 1u == (gen + 1u) * nloc) {
            __builtin_amdgcn_fence(__ATOMIC_RELEASE, "agent");
            asm volatile("s_waitcnt vmcnt(0)" ::: "memory");
            const unsigned og = xb_add(&bar[XB_TOP], 1u);
            const unsigned tg = og / nx;
            if (og + 1u == (tg + 1u) * nx) xb_add(&bar[XB_TOPGEN], 1u);
            else XB_SPIN(xb_ld(&bar[XB_TOPGEN]) == tg, bar);
            __builtin_amdgcn_fence(__ATOMIC_ACQUIRE, "agent");
            xb_add(&bar[XB_XGEN(b.x)], 1u);
            asm volatile("s_waitcnt vmcnt(0)" ::: "memory");
        } else {
            XB_SPIN(xb_ld(&bar[XB_XGEN(b.x)]) == gen, bar);
            __builtin_amdgcn_fence(__ATOMIC_ACQUIRE, "agent");
            asm volatile("s_waitcnt vmcnt(0)" ::: "memory");
        }
    }
    __syncthreads();
}

struct Frame {
    LAS unsigned char* lds;
    volatile LAS unsigned* MISC;
    gu32* ctl;
    int tid, lane, wave;
    int vcu, G;
    unsigned char* ws;
    const float *x, *c, *w_ada, *b_ada, *norm1_g, *w_in, *fox_q_norm, *fox_k_norm, *fox_f_bias, *gdn_conv_w, *gdn_a_log, *gdn_dt_bias, *gdn_norm_w, *w_out, *norm2_g, *w_gate, *w_up, *w_down;
    float* out;
};
__device__ __forceinline__ float wave_sum(float v) {
#pragma unroll
    for (int o = 1; o < 64; o <<= 1) v += __shfl_xor(v, o);
    return v;
}
__device__ __forceinline__ float sum16(float v) {
#pragma unroll
    for (int o = 1; o < 16; o <<= 1) v += __shfl_xor(v, o);
    return v;
}

template <bool NT> __device__ __forceinline__ void ada_task(Frame& F, int ks, int nc, int lane) {
    float* modp = (float*)(F.ws + WS_MODP);
    const int n = nc * 256 + lane * 4, k0 = ks * (DM / ADA_KS);
    const float* wp = F.w_ada + (size_t)k0 * NMOD + n;
    LAS unsigned char* scr = F.lds + RING_OFF + F.wave * 16640;
    f32x4 a0 = {0.f, 0.f, 0.f, 0.f}, a1 = {0.f, 0.f, 0.f, 0.f};
#define ADA_ISSUE(src, buf) do { _Pragma("unroll") for (int r_ = 0; r_ < 8; ++r_) \
        __builtin_amdgcn_global_load_lds((const unsigned*)((src) + (size_t)r_ * NMOD), (LAS unsigned*)((buf) + r_ * 1024), 16, 0, NT ? 2 : 0); } while (0)
#define ADA_EAT(buf, kb) do { _Pragma("unroll") for (int r = 0; r < 8; ++r) { const f32x4 w = *(const LAS f32x4*)((buf) + r * 1024 + lane * 16); \
        const float c0 = __builtin_bit_cast(float, __builtin_amdgcn_readlane(__builtin_bit_cast(int, c0v), (kb) + r)), c1 = __builtin_bit_cast(float, __builtin_amdgcn_readlane(__builtin_bit_cast(int, c1v), (kb) + r)); \
        a0 += w * c0; a1 += w * c1; } \
        asm volatile("s_waitcnt lgkmcnt(0)" ::: "memory"); } while (0)
    const float c0v = siluf_(F.c[k0 + lane]), c1v = siluf_(F.c[DM + k0 + lane]);
    ADA_ISSUE(wp, scr);
#pragma unroll 1
    for (int bt = 0; bt < 7; ++bt) {
        LAS unsigned char* cur = scr + (bt & 1) * 8192; LAS unsigned char* nxt = scr + ((bt + 1) & 1) * 8192;
        ADA_ISSUE(wp + (size_t)(bt + 1) * 8 * NMOD, nxt); asm volatile("s_waitcnt vmcnt(8)" ::: "memory");
        ADA_EAT(cur, bt * 8);
    }
    asm volatile("s_waitcnt vmcnt(0)" ::: "memory");
    ADA_EAT(scr + 8192, 56);
#undef ADA_EAT
#undef ADA_ISSUE
    *(f32x4*)(modp + (size_t)(ks * 2 + 0) * NMOD + n) = a0;
    *(f32x4*)(modp + (size_t)(ks * 2 + 1) * NMOD + n) = a1;
}
template <bool NT> __device__ __forceinline__ void p0_ada(Frame& F, int nc_lo, int nc_hi, int widx, int nworkers) {
    const int gw = widx * NWAVES + F.wave, NGW = nworkers * NWAVES;
    const int ncn = nc_hi - nc_lo;
    for (int task = gw; task < ADA_KS * ncn; task += NGW) ada_task<NT>(F, task / ncn, nc_lo + task % ncn, F.lane);
}
struct TrItem { const float* colp; bf16* dst; int ldw, K; };
template <bool NT> __device__ __forceinline__ void tr_load(f32x4 (&v)[16], const TrItem& it, int lane) {
    const int kq = lane >> 4;
#pragma unroll
    for (int i = 0; i < 16; ++i) { const f32x4* p = (const f32x4*)(it.colp + (size_t)(4 * i + kq) * it.ldw);
        v[i] = it.colp ? (NT ? __builtin_nontemporal_load(p) : *p) : (f32x4){0.f, 0.f, 0.f, 0.f}; }
}
template <bool NT> __device__ __forceinline__ void tr_store(const f32x4 (&v)[16], const TrItem& it, LAS float* scr, int lane) {
    const int kq = lane >> 4, g = lane & 15;
#pragma unroll
    for (int i = 0; i < 16; ++i) { LAS float* d = scr + (4 * i + kq) * 65 + 4 * g; d[0] = v[i].x; d[1] = v[i].y; d[2] = v[i].z; d[3] = v[i].w; }
    LDS_WAIT(); asm volatile("" ::: "memory");
    const int c = lane >> 3, rr = lane & 7;
#pragma unroll
    for (int j = 0; j < 8; ++j) { const int n = 8 * j + rr; const LAS float* s = scr + (8 * c) * 65 + n;
        v4u o; o.x = pk2(s[0 * 65], s[1 * 65]); o.y = pk2(s[2 * 65], s[3 * 65]); o.z = pk2(s[4 * 65], s[5 * 65]); o.w = pk2(s[6 * 65], s[7 * 65]);
        GAS v4u* q = (GAS v4u*)(it.dst + (size_t)n * it.K + 8 * c); if (NT) __builtin_nontemporal_store(o, q); else *q = o; }
    LDS_WAIT(); asm volatile("" ::: "memory");
}
__device__ __forceinline__ int win_srccol(int n) {
    if (n < PC_G) return n;
    if (n < PC_Z) return SRC_G + (n - PC_G);
    if (n < NP) return SRC_Z + (n - PC_Z);
    if (n < NP + 16) return SRC_F + (n - NP);
    if (n < NP + 32) return SRC_A + (n - NP - 16);
    if (n < NP + 48) return SRC_B + (n - NP - 32);
    return -1;
}
__device__ __forceinline__ TrItem p0_item(Frame& F, int it, int g4) {
    constexpr int I_IN = (DM / 64) * (NPT / 64), I_OUT = (DM / 64) * (DM / 64), I_GU = (DM / 64) * (2 * FF / 64);
    bf16* win_t = (bf16*)(F.ws + WS_WIN); bf16* wout_t = (bf16*)(F.ws + WS_WOUT); bf16* wgu_t = (bf16*)(F.ws + WS_WGU); bf16* wd_t = (bf16*)(F.ws + WS_WD);
    TrItem t; int r = it;
    if (r < I_IN) { const int kb = r % (DM / 64), nb = r / (DM / 64); const int sc = win_srccol(nb * 64 + g4);
        t.colp = sc >= 0 ? F.w_in + (size_t)(kb * 64) * IN_COLS + sc : nullptr; t.ldw = IN_COLS; t.K = LDWIN; t.dst = win_t + (size_t)(nb * 64) * LDWIN + kb * 64; return t; } r -= I_IN;
    if (r < I_OUT) { const int kb = r % (DM / 64), nb = r / (DM / 64);
        t.colp = F.w_out + (size_t)(kb * 64) * DM + nb * 64 + g4; t.ldw = DM; t.K = LDWOUT; t.dst = wout_t + (size_t)(nb * 64) * LDWOUT + kb * 64; return t; } r -= I_OUT;
    if (r < I_GU) { const int kb = r % (DM / 64), nb = r / (DM / 64); const int n = nb * 64 + g4;
        const float* src = ((n >> 7) & 1) ? F.w_up : F.w_gate;
        t.colp = src + (size_t)(kb * 64) * FF + (n >> 8) * 128 + (n & 127); t.ldw = FF; t.K = LDWGU; t.dst = wgu_t + (size_t)(nb * 64) * LDWGU + kb * 64; return t; } r -= I_GU;
    { const int kb = r % (FF / 64), nb = r / (FF / 64);
        t.colp = F.w_down + (size_t)(kb * 64) * DM + nb * 64 + g4; t.ldw = DM; t.K = FF; t.dst = wd_t + (size_t)(nb * 64) * FF + kb * 64; return t; }
}
constexpr int P0_ITEMS_ALL = (DM / 64) * (NPT / 64) + (DM / 64) * (DM / 64) + (DM / 64) * (2 * FF / 64) + (FF / 64) * (DM / 64);
constexpr int P0_ITEMS_IN = (DM / 64) * (NPT / 64);
constexpr int P6_ADA_WGS = 32;
constexpr int P6_CONV_WGS = 64;
constexpr int P0_ITEMS_DOWN = (FF / 64) * (DM / 64) * 7 / 8;
template <bool NT> __device__ __forceinline__ void p0_weights(Frame& F, int lo, int NITEMS, int widx, int nworkers) {
    LAS float* scr = (LAS float*)(F.lds + RING_OFF + F.wave * 16640);
    const int gw = widx * NWAVES + F.wave, NGW = nworkers * NWAVES;
    const int g4 = (F.lane & 15) * 4;
    f32x4 va[16], vb[16];
    int it = lo + gw; if (it >= NITEMS) return;
    TrItem ta = p0_item(F, it, g4), tb = ta;
    tr_load<NT>(va, ta, F.lane);
    for (;;) {
        const bool hb = it + NGW < NITEMS;
        if (hb) { tb = p0_item(F, it + NGW, g4); tr_load<NT>(vb, tb, F.lane); }
        tr_store<NT>(va, ta, scr, F.lane);
        if (!hb) break;
        const bool ha = it + 2 * NGW < NITEMS;
        if (ha) { ta = p0_item(F, it + 2 * NGW, g4); tr_load<NT>(va, ta, F.lane); }
        tr_store<NT>(vb, tb, scr, F.lane);
        if (!ha) break;
        it += 2 * NGW;
    }
}
__device__ __forceinline__ void p1_modreduce(Frame& F, int n_lo, int n_hi) {
    const float* modp = (const float*)(F.ws + WS_MODP); float* mod = (float*)(F.ws + WS_MOD);
    const int nn = n_hi - n_lo, ntask = 2 * nn / 64;
    LAS float* red = (LAS float*)(F.lds + RING_OFF);
    for (int task = F.vcu; task < ntask; task += F.G) {
        const int b = task / (nn / 64), n = n_lo + (task % (nn / 64)) * 64 + F.lane;
        const float* p = modp + (size_t)(F.wave * 8 * 2 + b) * NMOD + n;
        float v[8];
#pragma unroll
        for (int k = 0; k < 8; ++k) v[k] = p[(size_t)k * 2 * NMOD];
        red[F.wave * 64 + F.lane] = ((v[0] + v[1]) + (v[2] + v[3])) + ((v[4] + v[5]) + (v[6] + v[7]));
        __syncthreads();
        if (F.wave == 0) { float s = F.b_ada[n];
#pragma unroll
            for (int w = 0; w < NWAVES; ++w) s += red[w * 64 + F.lane];
            mod[(size_t)b * NMOD + n] = s; }
        __syncthreads();
    }
}
__device__ __forceinline__ void norm_mod_stage(Frame& F, const float* gain, int shift_chunk, int scale_chunk) {
    const float* mod = (const float*)(F.ws + WS_MOD);
    LAS f32x4* A4 = (LAS f32x4*)(F.lds + RING_OFF); LAS f32x4* S4 = A4 + 2 * (DM / 4);
#pragma unroll 1
    for (int b = 0; b < 2; ++b)
#pragma unroll 1
        for (int c4 = F.tid; c4 < DM / 4; c4 += NWAVES * 64) {
            const f32x4 g = ((const f32x4*)gain)[c4], sc = ((const f32x4*)(mod + (size_t)b * NMOD + scale_chunk * DM))[c4], sh = ((const f32x4*)(mod + (size_t)b * NMOD + shift_chunk * DM))[c4];
            A4[b * (DM / 4) + c4] = g * (1.0f + sc); S4[b * (DM / 4) + c4] = sh; }
    __syncthreads();
}
__device__ __forceinline__ void norm_mod_rows(Frame& F, const float* src, int ldh) {
    const int gw = F.vcu * NWAVES + F.wave, NGW = F.G * NWAVES;
    bf16* H = (bf16*)(F.ws + WS_H);
    const LAS f32x4* A4 = (const LAS f32x4*)(F.lds + RING_OFF); const LAS f32x4* S4 = A4 + 2 * (DM / 4);
#pragma unroll 1
    for (int row = gw; row < M; row += NGW) {
        const int b = row / SEQ;
        const GAS f32x4* xr = (const GAS f32x4*)(src + (size_t)row * DM) + F.lane;
        f32x4 v[16]; float ss = 0.f;
#pragma unroll
        for (int j = 0; j < 16; ++j) { v[j] = xr[64 * j]; ss += (v[j].x * v[j].x + v[j].y * v[j].y) + (v[j].z * v[j].z + v[j].w * v[j].w); }
        const float rstd = 1.0f / sqrtf(wave_sum(ss) * (1.0f / DM) + EPS);
        const LAS f32x4* ap = A4 + b * (DM / 4) + F.lane; const LAS f32x4* sp = S4 + b * (DM / 4) + F.lane;
        GAS v2u* o8 = (GAS v2u*)(H + (size_t)row * ldh) + F.lane;
#pragma unroll
        for (int j = 0; j < 16; ++j) { const f32x4 y = (v[j] * rstd) * ap[64 * j] + sp[64 * j];
            v2u w; w.x = pk2(y.x, y.y); w.y = pk2(y.z, y.w); o8[64 * j] = w;
            if ((j & 3) == 3) asm volatile("" ::: "memory"); }
    }
}
__device__ __forceinline__ void norm_mod_rows_b16(Frame& F, const bf16* src, int ldh) {
    const int gw = F.vcu * NWAVES + F.wave, NGW = F.G * NWAVES;
    bf16* H = (bf16*)(F.ws + WS_H);
    const LAS f32x4* A4 = (const LAS f32x4*)(F.lds + RING_OFF); const LAS f32x4* S4 = A4 + 2 * (DM / 4);
#pragma unroll 1
    for (int row = gw; row < M; row += NGW) {
        const int b = row / SEQ;
        const GAS v4u* xr = (const GAS v4u*)(src + (size_t)row * DM) + F.lane;
        v4u v[8]; float ss = 0.f;
#pragma unroll
        for (int j = 0; j < 8; ++j) { v[j] = xr[64 * j];
            const float e0 = bflo(v[j].x), e1 = bfhi(v[j].x), e2 = bflo(v[j].y), e3 = bfhi(v[j].y), e4 = bflo(v[j].z), e5 = bfhi(v[j].z), e6 = bflo(v[j].w), e7 = bfhi(v[j].w);
            ss += ((e0 * e0 + e1 * e1) + (e2 * e2 + e3 * e3)) + ((e4 * e4 + e5 * e5) + (e6 * e6 + e7 * e7)); }
        const float rstd = 1.0f / sqrtf(wave_sum(ss) * (1.0f / DM) + EPS);
        const LAS f32x4* ap = A4 + b * (DM / 4) + 2 * F.lane; const LAS f32x4* sp = S4 + b * (DM / 4) + 2 * F.lane;
        GAS v4u* o8 = (GAS v4u*)(H + (size_t)row * ldh) + F.lane;
#pragma unroll
        for (int j = 0; j < 8; ++j) {
            const f32x4 x0 = {bflo(v[j].x), bfhi(v[j].x), bflo(v[j].y), bfhi(v[j].y)}, x1 = {bflo(v[j].z), bfhi(v[j].z), bflo(v[j].w), bfhi(v[j].w)};
            const f32x4 y0 = (x0 * rstd) * ap[128 * j] + sp[128 * j], y1 = (x1 * rstd) * ap[128 * j + 1] + sp[128 * j + 1];
            v4u w; w.x = pk2(y0.x, y0.y); w.y = pk2(y0.z, y0.w); w.z = pk2(y1.x, y1.y); w.w = pk2(y1.z, y1.w); o8[64 * j] = w;
            if ((j & 1) == 1) asm volatile("" ::: "memory"); }
    }
}
__device__ __forceinline__ void p4_post(Frame& F) {
    const int gw = F.vcu * NWAVES + F.wave, NGW = F.G * NWAVES;
    bf16* P = (bf16*)(F.ws + WS_P);
    float* GG = (float*)(F.ws + WS_GG); float* GB = (float*)(F.ws + WS_GB); float* FLS = (float*)(F.ws + WS_FLS);
    const int l16 = F.lane & 15, sub = F.lane >> 4;
    for (int row = gw; row < M; row += NGW) {
        const int b = row / SEQ, t = row % SEQ;
        if (F.lane < 48) {
            const float* sp = (const float*)(F.ws + WS_SP) + (size_t)row * 64 + F.lane;
            float v = 0.f;
#pragma unroll
            for (int ks = 0; ks < 8; ++ks) v += sp[(size_t)ks * M * 64];
            const int h = F.lane & 15; const size_t o = (size_t)(b * NH + h) * SEQ + t;
            if (F.lane < 16) { const float z = v + F.fox_f_bias[h]; FLS[o] = (z < 0.f ? z : 0.f) - log1pf(expf(-fabsf(z))); }
            else if (F.lane < 32) { const float xs = v + F.gdn_dt_bias[h]; const float sp_ = xs > 20.f ? xs : log1pf(expf(xs)); GG[o] = -expf(F.gdn_a_log[h]) * sp_; }
            else GB[o] = 1.0f / (1.0f + expf(-v));
        }
    }
}
__device__ __forceinline__ void p5_kx(Frame& F) {
    if (F.wave != 0) return;
    for (int item = F.vcu; item < BATCH * NH * 8; item += F.G) {
        const int bh = item >> 3, sg = item & 7;
        const float* fls = (const float*)(F.ws + WS_FLS) + (size_t)bh * SEQ; bf16* KX = (bf16*)(F.ws + WS_KX);
        float pre = 0.f;
#pragma unroll
        for (int j = 0; j < 14; ++j) { const bool ok = j < 2 * sg;
            const f32x4 v = *(const f32x4*)(fls + (size_t)(ok ? F.lane * 2 * sg + j : 0) * 4); pre += ok ? (v.x + v.y) + (v.z + v.w) : 0.f; }
        pre = wave_sum(pre);
        const float* fp = fls + sg * 512 + F.lane * 8;
        const f32x4 v0 = *(const f32x4*)fp, v1 = *(const f32x4*)(fp + 4);
        float ls[8]; float tot = 0.f;
        tot += v0.x; ls[0] = tot; tot += v0.y; ls[1] = tot; tot += v0.z; ls[2] = tot; tot += v0.w; ls[3] = tot;
        tot += v1.x; ls[4] = tot; tot += v1.y; ls[5] = tot; tot += v1.z; ls[6] = tot; tot += v1.w; ls[7] = tot;
        float incl = tot;
#pragma unroll
        for (int o = 1; o < 64; o <<= 1) { const float u = __shfl_up(incl, o); if (F.lane >= o) incl += u; }
        const float base = pre + incl - tot;
        GAS v4u* kx = (GAS v4u*)(KX + ((size_t)bh * SEQ + sg * 512 + F.lane * 8) * 8);
#pragma unroll
        for (int i = 0; i < 8; ++i) { const float xj = -11.313708498984761f * (base + ls[i]);
            const unsigned hi_ = f2bf(xj); const float r1 = xj - __builtin_bit_cast(float, hi_ << 16);
            const unsigned mid_ = f2bf(r1); const float r2 = r1 - __builtin_bit_cast(float, mid_ << 16);
            const unsigned lo_ = f2bf(r2);
            v4u w; w.x = hi_ | (mid_ << 16); w.y = lo_; w.z = 0u; w.w = 0u; kx[i] = w; }
    }
}
__device__ __forceinline__ fox::BlockRef fox_ref(int bh, int qb) {
    const int b = bh / NH, h = bh % NH;
    fox::BlockRef r;
    r.q = (unsigned)((b * SEQ + qb * 256) * NPP + PC_Q + h * HD);
    r.k = (unsigned)((b * SEQ) * NPP + PC_K + h * HD);
    r.v = (unsigned)((b * SEQ) * NPP + PC_V + h * HD);
    r.kx = (unsigned)(bh * SEQ);
    r.o = (unsigned)((b * SEQ + qb * 256) * LDMIX + h * HD);
    r.P0 = qb * 256;
    return r;
}
__device__ __forceinline__ fox::BlockRef fox_item(int L) { return fox_ref(L & 31, 15 - (L >> 5)); }
__device__ __forceinline__ int fox_fetch(Frame& F) {
    __syncthreads();
    if (F.tid == 0) F.MISC[16] = __hip_atomic_fetch_add(F.ctl + CW_QUEUE, 1u, RLX_AGENT);
    __syncthreads();
    return (int)F.MISC[16];
}
__device__ __forceinline__ void p5_fox(Frame& F, char* lds) {
    constexpr int TOTAL = BATCH * NH * (SEQ / 256);
    int cur = fox_fetch(F); if (cur >= TOTAL) return;
    int nxt = fox_fetch(F);
    const fox::Bases Bs{(const bf16*)(F.ws + WS_P), (const bf16*)(F.ws + WS_KX), (bf16*)(F.ws + WS_MIX)};
    fox::Seam S;
    { const fox::BlockRef c0 = fox_item(cur); fox::fox_prime<NPP, LDMIX>(Bs, c0, lds, S); }
    for (;;) {
        const bool has_next = nxt < TOTAL;
        const fox::BlockRef c = fox_item(cur), nx = fox_item(has_next ? nxt : cur);
        fox::fox_block<NPP, LDMIX>(Bs, c, nx, lds, S);
        if (!has_next) break;
        cur = nxt; nxt = fox_fetch(F);
    }
}
__device__ __forceinline__ void p6_gdn_out(Frame& F) {
    const int gw = F.vcu * NWAVES + F.wave, NGW = F.G * NWAVES;
    const bf16* P = (const bf16*)(F.ws + WS_P); bf16* MIX = (bf16*)(F.ws + WS_MIX); const bf16* GO = (const bf16*)(F.ws + WS_GO);
    const int l16 = F.lane & 15, sub = F.lane >> 4;
    for (int row = gw; row < M; row += NGW) {
        const int b = row / SEQ, t = row % SEQ;
#pragma unroll
        for (int it = 0; it < 4; ++it) {
            const int h = it * 4 + sub;
            const v4u ow = *(const GAS v4u*)(GO + ((size_t)(b * NH + h) * SEQ + t) * HD + l16 * 8);
            const f32x4 o0 = {bflo(ow.x), bfhi(ow.x), bflo(ow.y), bfhi(ow.y)}, o1 = {bflo(ow.z), bfhi(ow.z), bflo(ow.w), bfhi(ow.w)};
            const v4u zw = *(const GAS v4u*)(P + (size_t)row * NPP + PC_Z + h * HD + l16 * 8);
            float ss = (o0.x * o0.x + o0.y * o0.y) + (o0.z * o0.z + o0.w * o0.w) + (o1.x * o1.x + o1.y * o1.y) + (o1.z * o1.z + o1.w * o1.w);
            const float rstd = 1.0f / sqrtf(sum16(ss) * (1.0f / HD) + EPS);
            const float* gn = F.gdn_norm_w + l16 * 8; const f32x4 g0 = *(const f32x4*)gn, g1 = *(const f32x4*)(gn + 4);
            v4u w;
            w.x = pk2(o0.x * rstd * g0.x * siluf_(bflo(zw.x)), o0.y * rstd * g0.y * siluf_(bfhi(zw.x)));
            w.y = pk2(o0.z * rstd * g0.z * siluf_(bflo(zw.y)), o0.w * rstd * g0.w * siluf_(bfhi(zw.y)));
            w.z = pk2(o1.x * rstd * g1.x * siluf_(bflo(zw.z)), o1.y * rstd * g1.y * siluf_(bfhi(zw.z)));
            w.w = pk2(o1.z * rstd * g1.z * siluf_(bflo(zw.w)), o1.w * rstd * g1.w * siluf_(bfhi(zw.w)));
            *(GAS v4u*)(MIX + (size_t)row * LDMIX + FOXW + h * HD + l16 * 8) = w;
        }
    }
}

typedef short gbf16x8 __attribute__((ext_vector_type(8)));
typedef float gf32x16 __attribute__((ext_vector_type(16)));
typedef float gf32x2 __attribute__((ext_vector_type(2))); typedef __bf16 gbf16x2 __attribute__((ext_vector_type(2)));
__device__ __forceinline__ unsigned gcvtpk(float lo, float hi) { gf32x2 v = {lo, hi}; gbf16x2 b = __builtin_convertvector(v, gbf16x2); return __builtin_bit_cast(unsigned, b); }
__device__ __forceinline__ gbf16x8 gpack8(f32x4 a, f32x4 b) { v4u w = {gcvtpk(a[0], a[1]), gcvtpk(a[2], a[3]), gcvtpk(b[0], b[1]), gcvtpk(b[2], b[3])}; return __builtin_bit_cast(gbf16x8, w); }
__device__ __forceinline__ int gcrow(int r, int hi) { return (r & 3) + 8 * (r >> 2) + 4 * hi; }
__device__ __forceinline__ float gbf(unsigned short h) { return __builtin_bit_cast(float, (unsigned)h << 16); }
constexpr int GP_TAB = 0, GP_AMAT = 2048, GP_TB = GP_AMAT + 17408, GP_TILES = GP_TB + 9216, GP_TS = 272, GP_TILE = 64 * GP_TS, GP_SET = 3 * GP_TILE;
constexpr int GP_CW = GP_TILES + 2 * GP_SET;
static_assert(GP_CW + 6144 <= PHASE_LDS, "chunk-prep LDS map");
__device__ __forceinline__ void gp_tables(Frame& F, int cidx, LAS float* Gs, int lane) {
    const float* GG = (const float*)(F.ws + WS_GG); const float* GB = (const float*)(F.ws + WS_GB); float* GT = (float*)(F.ws + WS_GT);
    const size_t tok0 = (size_t)(cidx >> 6) * SEQ + (cidx & 63) * 64;
    const float gi = GG[tok0 + lane], bi = GB[tok0 + lane];
    float G = gi;
#pragma unroll
    for (int o = 1; o < 64; o <<= 1) { const float u = __shfl_up(G, o); if (lane >= o) G += u; }
    const float G63 = __shfl(G, 63);
    Gs[lane] = G; Gs[64 + lane] = bi; Gs[128 + lane] = __expf(G); Gs[192 + lane] = __expf(G63 - G);
    if (lane == 63) GT[cidx] = __expf(G);
    const int h = (cidx >> 6) & 15; LAS float* cwl = (LAS float*)(F.lds + GP_CW);
#pragma unroll
    for (int r = 0; r < 12; ++r) { const int type = r >> 2, tap = r & 3;
        const float* src = F.gdn_conv_w + (size_t)tap * 6144 + type * GDNW + h * HD + 2 * lane;
        cwl[r * 128 + 2 * lane] = src[0]; cwl[r * 128 + 2 * lane + 1] = src[1]; }
}
template <int NW> struct GpTaps { static constexpr int NP_ = (192 + 4 * NW - 1) / (4 * NW); v4u xw[NP_][4]; };
template <int NW>
__device__ __forceinline__ void gp_stage0_load(Frame& F, int cidx, int w, int lane, GpTaps<NW>& tp) {

    constexpr int NP_ = (192 + 4 * NW - 1) / (4 * NW);
    const bf16* P = (const bf16*)(F.ws + WS_P);
    const int c = lane & 15, sub = lane >> 4;
    const int bh = cidx >> 6, n = cidx & 63, b = bh >> 4, h = bh & 15;
#pragma unroll
    for (int it = 0; it < NP_; ++it) {
        int pi = it * 4 * NW + 4 * w + sub; if (pi > 191) pi = 191;
        const int type = pi >> 6, i = pi & 63, t = n * 64 + i;
        const bf16* prow = P + (size_t)(b * SEQ + t) * NPP + PC_G + type * GDNW + h * HD + c * 8;
#pragma unroll
        for (int tap = 0; tap < 4; ++tap) { const int dt = 3 - tap; const bool ok = t - dt >= 0;
            tp.xw[it][tap] = *(const GAS v4u*)(prow - (size_t)(ok ? dt : 0) * NPP);
            if (!ok) tp.xw[it][tap] = (v4u){0u, 0u, 0u, 0u}; }
    }
}
template <int NW>
__device__ __forceinline__ void gp_stage0_compute(Frame& F, int cidx, const LAS float* Gs, LAS unsigned char* tiles, int w, int lane, const GpTaps<NW>& tp) {

    constexpr int NP_ = (192 + 4 * NW - 1) / (4 * NW);
    const int c = lane & 15, sub = lane >> 4;
    const int bh = cidx >> 6, n = cidx & 63, b = bh >> 4, h = bh & 15;
    unsigned char* CH = F.ws + WS_CH + (size_t)cidx * CH_BYTES;
    const LAS float* cwl = (const LAS float*)(F.lds + GP_CW);
#pragma unroll
    for (int it = 0; it < NP_; ++it) {
        const int pi = it * 4 * NW + 4 * w + sub;
        if (pi < 192) {
            const int type = pi >> 6, i = pi & 63;
            float acc[8];
#pragma unroll
            for (int e = 0; e < 8; ++e) acc[e] = 0.f;
#pragma unroll
            for (int tap = 0; tap < 4; ++tap) {
                const v4u xv = tp.xw[it][tap];
                const LAS float* cw = cwl + (type * 4 + tap) * 128 + c * 8;
                const f32x4 c0 = *(const LAS f32x4*)cw, c1 = *(const LAS f32x4*)(cw + 4);
                acc[0] += bflo(xv.x) * c0.x; acc[1] += bfhi(xv.x) * c0.y; acc[2] += bflo(xv.y) * c0.z; acc[3] += bfhi(xv.y) * c0.w;
                acc[4] += bflo(xv.z) * c1.x; acc[5] += bfhi(xv.z) * c1.y; acc[6] += bflo(xv.w) * c1.z; acc[7] += bfhi(xv.w) * c1.w;
            }
            float ss = 0.f;
#pragma unroll
            for (int e = 0; e < 8; ++e) { acc[e] = siluf_(acc[e]); ss += acc[e] * acc[e]; }
            ss = sum16(ss);
            float sc = 1.0f;
            if (type < 2) sc = __builtin_amdgcn_rsqf(ss + EPS);
            if (type == 0) sc *= 0.08838834764831845f;
#pragma unroll
            for (int e = 0; e < 8; ++e) acc[e] *= sc;
            const v4u o = {gcvtpk(acc[0], acc[1]), gcvtpk(acc[2], acc[3]), gcvtpk(acc[4], acc[5]), gcvtpk(acc[6], acc[7])};
            *(LAS v4u*)(tiles + type * GP_TILE + i * GP_TS + c * 16) = o;
            if (type == 0) {
                const float e_ = Gs[128 + i];
                v2u w0 = {gcvtpk(acc[0] * e_, acc[1] * e_), gcvtpk(acc[2] * e_, acc[3] * e_)}, w1 = {gcvtpk(acc[4] * e_, acc[5] * e_), gcvtpk(acc[6] * e_, acc[7] * e_)};
                *(GAS v2u*)(CH + CH_Q + i * RS_W + c * 16) = w0; *(GAS v2u*)(CH + CH_Q + i * RS_W + c * 16 + 8) = w1;
            }
        }
        asm volatile("" ::: "memory");
    }
}
template <int NW>
__device__ __forceinline__ void gp_stage0(Frame& F, int cidx, const LAS float* Gs, LAS unsigned char* tiles, int w, int lane) { GpTaps<NW> tp; gp_stage0_load<NW>(F, cidx, w, lane, tp); gp_stage0_compute<NW>(F, cidx, Gs, tiles, w, lane, tp); }
#ifndef GP_PROBE
#define GP_PROBE 0
#endif
#define GP_BAR() do { asm volatile("s_waitcnt lgkmcnt(0)" ::: "memory"); __builtin_amdgcn_s_barrier(); asm volatile("" ::: "memory"); } while (0)
__device__ __forceinline__ void gdn_chunk_prep(Frame& F) {
    LAS float* Amat = (LAS float*)(F.lds + GP_AMAT);
    LAS bf16* Tb = (LAS bf16*)(F.lds + GP_TB);
    constexpr int TS = GP_TS;
    const int wave = F.wave;
    int cidx = F.vcu; if (cidx >= NCHUNK) return;
    { int tid0 = F.tid; asm volatile("" : "+v"(tid0)); const int lane0 = tid0 & 63;
      if (wave == 0) gp_tables(F, cidx, (LAS float*)(F.lds + GP_TAB), lane0);
      GP_BAR();
      gp_stage0<8>(F, cidx, (const LAS float*)(F.lds + GP_TAB), F.lds + GP_TILES, wave, lane0);
      GP_BAR(); }
    for (int k = 0; cidx < NCHUNK; cidx += F.G, ++k) {
        int tid_ = F.tid; asm volatile("" : "+v"(tid_));
        const int lane = tid_ & 63, r32 = lane & 31, hi = lane >> 5;
        const int cur = k & 1, ncidx = cidx + F.G; const bool has_next = ncidx < NCHUNK;
        const LAS float* Gs = (const LAS float*)(F.lds + GP_TAB + cur * 1024); const LAS float* Bs = Gs + 64; const LAS float* EGs = Gs + 128; const LAS float* EGTs = Gs + 192;
        LAS unsigned char* qs = F.lds + GP_TILES + cur * GP_SET; LAS unsigned char* ks = qs + GP_TILE; LAS unsigned char* vs = ks + GP_TILE;
        unsigned char* CH = F.ws + WS_CH + (size_t)cidx * CH_BYTES;
        for (int rep_ = 0; rep_ < ((GP_PROBE & 1) ? 2 : 1); ++rep_)
        if (wave < 6) {
            const int typ = wave / 3, blk = wave % 3, I = blk ? 1 : 0, J = blk == 2 ? 1 : 0;
            const LAS unsigned char* Ap = (typ ? qs : ks) + (32 * I + r32) * TS + hi * 16;
            const LAS unsigned char* Bp = ks + (32 * J + r32) * TS + hi * 16;
            gf32x16 acc = {};
#pragma unroll
            for (int kk = 0; kk < 8; ++kk) {
                const gbf16x8 a = *(const LAS gbf16x8*)(Ap + kk * 32), bq = *(const LAS gbf16x8*)(Bp + kk * 32);
                acc = __builtin_amdgcn_mfma_f32_32x32x16_bf16(a, bq, acc, 0, 0, 0);
            }
            const int j = 32 * J + r32; const float Gj = Gs[j];
#pragma unroll
            for (int q = 0; q < 16; ++q) {
                const int i = 32 * I + gcrow(q, hi);
                const float val = acc[q] * __expf(Gs[i] - Gj);
                if (typ == 0) { if (i > j) Amat[i * 68 + j] = Bs[i] * val; }
                else { *(LAS bf16*)((LAS unsigned char*)Tb + i * RS_K + j * 2) = (bf16)f2bf(i >= j ? val : 0.f); }
            }
        } else {
            const int t = tid_ - 384;
#pragma unroll 4
            for (int ig = 0; ig < 16; ++ig) {
                const float x0 = gbf(*(const LAS bf16*)(ks + (4 * ig) * TS + t * 2)) * EGTs[4 * ig], x1 = gbf(*(const LAS bf16*)(ks + (4 * ig + 1) * TS + t * 2)) * EGTs[4 * ig + 1];
                const float x2 = gbf(*(const LAS bf16*)(ks + (4 * ig + 2) * TS + t * 2)) * EGTs[4 * ig + 2], x3 = gbf(*(const LAS bf16*)(ks + (4 * ig + 3) * TS + t * 2)) * EGTs[4 * ig + 3];
                v2u w = {gcvtpk(x0, x1), gcvtpk(x2, x3)};
                *(GAS v2u*)(CH + CH_KT + t * RS_K + ig * 8) = w;
            }
        }
        GP_BAR();
        if (wave == 0) {
            float T[64];
#pragma unroll
            for (int i = 0; i < 50; i += 2) {
                float a = (i == lane) ? 1.f : 0.f, bq = (i + 1 == lane) ? 1.f : 0.f;
#pragma unroll
                for (int j = 0; j < i; ++j) { a = fmaf(-Amat[i * 68 + j], T[j], a); bq = fmaf(-Amat[(i + 1) * 68 + j], T[j], bq); }
                T[i] = a;
                T[i + 1] = fmaf(-Amat[(i + 1) * 68 + i], a, bq);
                asm volatile("" ::: "memory");
            }
            GP_BAR();
#pragma unroll
            for (int i = 50; i < 64; i += 2) {
                float a = (i == lane) ? 1.f : 0.f, bq = (i + 1 == lane) ? 1.f : 0.f;
#pragma unroll
                for (int j = 0; j < i; ++j) { a = fmaf(-Amat[i * 68 + j], T[j], a); bq = fmaf(-Amat[(i + 1) * 68 + j], T[j], bq); }
                T[i] = a;
                T[i + 1] = fmaf(-Amat[(i + 1) * 68 + i], a, bq);
                asm volatile("" ::: "memory");
            }
#pragma unroll
            for (int i = 0; i < 64; ++i) Tb[i * 72 + lane] = (bf16)f2bf(T[i]);
        } else {
            GpTaps<7> tp;
            gp_stage0_load<7>(F, has_next ? ncidx : cidx, wave - 1, lane, tp);
            if (wave == 1) { if (has_next) gp_tables(F, ncidx, (LAS float*)(F.lds + GP_TAB + (cur ^ 1) * 1024), lane); }
            else {
                const int t = tid_ - 128;
                for (int x = t; x < 544; x += 384) *(GAS v4u*)(CH + CH_AQ + x * 16) = *(const LAS v4u*)((LAS unsigned char*)Tb + x * 16);
                if (k > 0) { unsigned char* CHp = F.ws + WS_CH + (size_t)(cidx - F.G) * CH_BYTES; const LAS unsigned char* wi = F.lds + GP_TILES + (cur ^ 1) * GP_SET;
                    for (int x = t; x < 1056; x += 384) *(GAS v4u*)(CHp + CH_W + x * 16) = *(const LAS v4u*)(wi + x * 16); }
            }
            GP_BAR();
            if (has_next) gp_stage0_compute<7>(F, ncidx, (const LAS float*)(F.lds + GP_TAB + (cur ^ 1) * 1024), F.lds + GP_TILES + (cur ^ 1) * GP_SET, wave - 1, lane, tp);
        }
        GP_BAR();
        for (int rep_ = 0; rep_ < ((GP_PROBE & 4) ? 2 : 1); ++rep_) {
            const int nb = wave & 3, isU = wave >> 2;
            const LAS unsigned char* src = (isU ? vs : ks) + (32 * nb + r32) * 2;
            gf32x16 acc0 = {}, acc1 = {};
#pragma unroll
            for (int kk = 0; kk < 4; ++kk) {
                float x[8];
#pragma unroll
                for (int jj = 0; jj < 8; ++jj) { const int j = 16 * kk + 8 * hi + jj; const float sc = isU ? Bs[j] : Bs[j] * EGs[j]; x[jj] = gbf(*(const LAS bf16*)(src + j * TS)) * sc; }
                const v4u bw = {gcvtpk(x[0], x[1]), gcvtpk(x[2], x[3]), gcvtpk(x[4], x[5]), gcvtpk(x[6], x[7])};
                const gbf16x8 bq = __builtin_bit_cast(gbf16x8, bw);
                const gbf16x8 a0 = *(const LAS gbf16x8*)((LAS unsigned char*)Tb + r32 * 144 + (16 * kk + 8 * hi) * 2);
                const gbf16x8 a1 = *(const LAS gbf16x8*)((LAS unsigned char*)Tb + (32 + r32) * 144 + (16 * kk + 8 * hi) * 2);
                acc0 = __builtin_amdgcn_mfma_f32_32x32x16_bf16(a0, bq, acc0, 0, 0, 0);
                acc1 = __builtin_amdgcn_mfma_f32_32x32x16_bf16(a1, bq, acc1, 0, 0, 0);
            }
            if (isU) {
                float* up = (float*)(F.ws + WS_UC) + ((size_t)(cidx * 2 + 0) * 4 + nb) * 1024 + lane * 16;
#pragma unroll
                for (int v = 0; v < 4; ++v) { *(f32x4*)(up + 4 * v) = (f32x4){acc0[4 * v], acc0[4 * v + 1], acc0[4 * v + 2], acc0[4 * v + 3]};
                                              *(f32x4*)(up + 4096 + 4 * v) = (f32x4){acc1[4 * v], acc1[4 * v + 1], acc1[4 * v + 2], acc1[4 * v + 3]}; }
            } else {
#pragma unroll
                for (int q = 0; q < 16; ++q) { const int i = gcrow(q, hi);
                    *(LAS bf16*)(qs + i * RS_W + (32 * nb + r32) * 2) = (bf16)f2bf(-acc0[q]);
                    *(LAS bf16*)(qs + (32 + i) * RS_W + (32 * nb + r32) * 2) = (bf16)f2bf(-acc1[q]); }
            }
        }
        GP_BAR();
    }
    {
        int tid_ = F.tid; asm volatile("" : "+v"(tid_));
        const int last = cidx - F.G, kl = (last - F.vcu) / F.G;
        unsigned char* CHp = F.ws + WS_CH + (size_t)last * CH_BYTES; const LAS unsigned char* wi = F.lds + GP_TILES + (kl & 1) * GP_SET;
        for (int x = tid_; x < 1056; x += NWAVES * 64) *(GAS v4u*)(CHp + CH_W + x * 16) = *(const LAS v4u*)(wi + x * 16);
    }
}
#undef GP_BAR
__device__ __forceinline__ gbf16x8 gdn_ldfrag(const LAS unsigned char* p) {
    const v2u lo = *(const LAS v2u*)p, hi8 = *(const LAS v2u*)(p + 16);
    const v4u w = {lo.x, lo.y, hi8.x, hi8.y}; return __builtin_bit_cast(gbf16x8, w);
}
__device__ __forceinline__ gbf16x8 gdn_accfrag(const gf32x16& x, int s) {
    const v4u w = {gcvtpk(x[8 * s], x[8 * s + 1]), gcvtpk(x[8 * s + 2], x[8 * s + 3]), gcvtpk(x[8 * s + 4], x[8 * s + 5]), gcvtpk(x[8 * s + 6], x[8 * s + 7])};
    return __builtin_bit_cast(gbf16x8, w);
}
#define GDN_BAR() do { asm volatile("s_waitcnt lgkmcnt(0)" ::: "memory"); __builtin_amdgcn_s_barrier(); asm volatile("" ::: "memory"); } while (0)
__device__ __forceinline__ void gdn_scan(Frame& F, int bh) {
    const int lane = F.lane, wave = F.wave, c = lane & 31, hi = lane >> 5;
    const unsigned char* CHB = F.ws + WS_CH + (size_t)(bh * 64) * CH_BYTES;
    if (wave >= 4) {
        const unsigned char* src = CHB + (wave - 4) * 1024 + lane * 16;
#pragma unroll
        for (int i = 0; i < 15; ++i) __builtin_amdgcn_global_load_lds((const unsigned*)(src + i * 4096), (LAS unsigned*)(F.lds + (i * 4 + (wave - 4)) * 1024), 16, 0, 0);
        asm volatile("s_waitcnt vmcnt(0)" ::: "memory"); GDN_BAR();
        for (int n = 0; n < 64; ++n) {
            if (n + 1 < 64) { const unsigned char* s2 = src + (size_t)(n + 1) * CH_BYTES; const int boff = ((n + 1) & 1) * CH_BYTES;
#pragma unroll
                for (int i = 0; i < 15; ++i) __builtin_amdgcn_global_load_lds((const unsigned*)(s2 + i * 4096), (LAS unsigned*)(F.lds + boff + (i * 4 + (wave - 4)) * 1024), 16, 0, 0); }
            asm volatile("s_waitcnt vmcnt(0)" ::: "memory"); GDN_BAR();
        }
    } else {
        const float* UC = (const float*)(F.ws + WS_UC) + (size_t)(bh * 64) * 8192 + wave * 1024 + lane * 16;
        const float* GT = (const float*)(F.ws + WS_GT) + bh * 64;
        bf16* GO = (bf16*)(F.ws + WS_GO) + (size_t)bh * SEQ * HD + 32 * wave + c;
        const int roW = c * RS_W + hi * 8, roK = c * RS_K + hi * 8;
        gf32x16 S0 = {}, S1 = {}, S2 = {}, S3 = {};
        gbf16x8 Sb00, Sb01, Sb10, Sb11, Sb20, Sb21, Sb30, Sb31;
        Sb00 = (gbf16x8){0, 0, 0, 0, 0, 0, 0, 0}; Sb01 = Sb00; Sb10 = Sb00; Sb11 = Sb00; Sb20 = Sb00; Sb21 = Sb00; Sb30 = Sb00; Sb31 = Sb00;
        float gtn = GT[0];
        gf32x16 Un0 = *(const gf32x16*)UC, Un1 = *(const gf32x16*)(UC + 4096);
        GDN_BAR();
#define LDF(dst, base, o8) const gbf16x8 dst = gdn_ldfrag(Bp + (base) + (o8) * 8)
#define MF(acc, f, bop) acc = __builtin_amdgcn_mfma_f32_32x32x16_bf16(f, bop, acc, 0, 0, 0)
#define SB() __builtin_amdgcn_sched_barrier(0)
        for (int n = 0; n < 64; ++n) {
            const LAS unsigned char* Bp = F.lds + (n & 1) * CH_BYTES;
            const int bW0 = CH_W + roW, bW1 = bW0 + 32 * RS_W, bQ0 = CH_Q + roW, bQ1 = bQ0 + 32 * RS_W, bA0 = CH_AQ + roK, bA1 = bA0 + 32 * RS_K;
            const int bK0 = CH_KT + roK, bK1 = bK0 + 32 * RS_K, bK2 = bK0 + 64 * RS_K, bK3 = bK0 + 96 * RS_K;
            const float gt = gtn;
            gf32x16 V0 = Un0, V1 = Un1, O0 = {}, O1 = {};
            if (n + 1 < 64) { gtn = GT[n + 1]; SB(); Un0 = *(const gf32x16*)(UC + (size_t)(n + 1) * 8192); Un1 = *(const gf32x16*)(UC + (size_t)(n + 1) * 8192 + 4096); }
            SB();
            LDF(w00, bW0, 0); LDF(w01, bW1, 0); LDF(w02, bW0, 4); LDF(w03, bW1, 4); SB();
            LDF(w10, bW0, 8); LDF(w11, bW1, 8); LDF(w12, bW0, 12); LDF(w13, bW1, 12); SB();
            MF(V0, w00, Sb00); MF(V1, w01, Sb00); MF(V0, w02, Sb01); MF(V1, w03, Sb01); SB();
            LDF(w20, bW0, 16); LDF(w21, bW1, 16); LDF(w22, bW0, 20); LDF(w23, bW1, 20); SB();
            MF(V0, w10, Sb10); MF(V1, w11, Sb10); MF(V0, w12, Sb11); MF(V1, w13, Sb11); SB();
            LDF(w30, bW0, 24); LDF(w31, bW1, 24); LDF(w32, bW0, 28); LDF(w33, bW1, 28); SB();
            MF(V0, w20, Sb20); MF(V1, w21, Sb20); MF(V0, w22, Sb21); MF(V1, w23, Sb21); SB();
            LDF(q00, bQ0, 0); LDF(q01, bQ1, 0); LDF(q02, bQ0, 4); LDF(q03, bQ1, 4); SB();
            MF(V0, w30, Sb30); MF(V1, w31, Sb30); MF(V0, w32, Sb31); MF(V1, w33, Sb31); SB();
            LDF(q10, bQ0, 8); LDF(q11, bQ1, 8); LDF(q12, bQ0, 12); LDF(q13, bQ1, 12); SB();
            MF(O0, q00, Sb00); MF(O1, q01, Sb00); MF(O0, q02, Sb01); MF(O1, q03, Sb01); SB();
            LDF(q20, bQ0, 16); LDF(q21, bQ1, 16); LDF(q22, bQ0, 20); LDF(q23, bQ1, 20); SB();
            MF(O0, q10, Sb10); MF(O1, q11, Sb10); MF(O0, q12, Sb11); MF(O1, q13, Sb11); S0 = S0 * gt; S1 = S1 * gt; SB();
            LDF(q30, bQ0, 24); LDF(q31, bQ1, 24); LDF(q32, bQ0, 28); LDF(q33, bQ1, 28); SB();
            MF(O0, q20, Sb20); MF(O1, q21, Sb20); MF(O0, q22, Sb21); MF(O1, q23, Sb21); S2 = S2 * gt; S3 = S3 * gt; SB();
            LDF(x0, bA0, 0); LDF(x1, bA1, 0); LDF(x2, bA1, 8); LDF(x3, bA0, 4); SB();
            MF(O0, q30, Sb30); MF(O1, q31, Sb30); MF(O0, q32, Sb31); MF(O1, q33, Sb31); SB();
            const gbf16x8 Vb00 = gdn_accfrag(V0, 0), Vb01 = gdn_accfrag(V0, 1), Vb10 = gdn_accfrag(V1, 0), Vb11 = gdn_accfrag(V1, 1);
            LDF(x4, bA1, 4); LDF(x5, bA1, 12); LDF(k00, bK0, 0); LDF(k01, bK1, 0); SB();
            MF(O0, x0, Vb00); MF(O1, x1, Vb00); MF(O1, x2, Vb10); MF(O0, x3, Vb01); SB();
            LDF(k02, bK2, 0); LDF(k03, bK3, 0); LDF(k10, bK0, 4); LDF(k11, bK1, 4); SB();
            MF(O1, x4, Vb01); MF(O1, x5, Vb11);
            MF(S0, k00, Vb00); MF(S1, k01, Vb00); SB();
            LDF(k12, bK2, 4); LDF(k13, bK3, 4); LDF(k20, bK0, 8); LDF(k21, bK1, 8); SB();
            MF(S2, k02, Vb00); MF(S3, k03, Vb00); MF(S0, k10, Vb01); MF(S1, k11, Vb01); SB();
            LDF(k22, bK2, 8); LDF(k23, bK3, 8); LDF(k30, bK0, 12); LDF(k31, bK1, 12); SB();
            MF(S2, k12, Vb01); MF(S3, k13, Vb01); MF(S0, k20, Vb10); MF(S1, k21, Vb10); SB();
            LDF(k32, bK2, 12); LDF(k33, bK3, 12); SB();
            MF(S2, k22, Vb10); MF(S3, k23, Vb10); MF(S0, k30, Vb11); MF(S1, k31, Vb11); SB();
            MF(S2, k32, Vb11); MF(S3, k33, Vb11); SB();
            bf16* op = GO + (size_t)(n * 64) * HD;
#pragma unroll
            for (int q = 0; q < 16; ++q) { const int i = gcrow(q, hi); op[(size_t)i * HD] = (bf16)gcvtpk(O0[q], O0[q]); op[(size_t)(32 + i) * HD] = (bf16)gcvtpk(O1[q], O1[q]); }
            Sb00 = gdn_accfrag(S0, 0); Sb01 = gdn_accfrag(S0, 1); Sb10 = gdn_accfrag(S1, 0); Sb11 = gdn_accfrag(S1, 1);
            Sb20 = gdn_accfrag(S2, 0); Sb21 = gdn_accfrag(S2, 1); Sb30 = gdn_accfrag(S3, 0); Sb31 = gdn_accfrag(S3, 1);
            GDN_BAR();
        }
#undef LDF
#undef MF
#undef SB
    }
}
#undef GDN_BAR
struct Args { const float* in[18]; float* out; unsigned char* ws; int ph_lo, ph_hi; };
__global__ void __launch_bounds__(NWAVES * 64, 2) hyb_fwd(Args args) {
    extern __shared__ __attribute__((aligned(16))) unsigned char lds[];
    Frame F;
    F.lds = (LAS unsigned char*)lds;
    F.MISC = (volatile LAS unsigned*)(F.lds + MISC_OFF);
    F.tid = threadIdx.x; F.lane = F.tid & 63; F.wave = __builtin_amdgcn_readfirstlane(F.tid >> 6);
    F.G = gridDim.x; { const int bx = blockIdx.x; F.vcu = (F.G % 8 == 0) ? (bx % 8) * (F.G / 8) + bx / 8 : bx; }
    F.ws = args.ws; F.ctl = (gu32*)(args.ws + WS_CTL);
    F.x = args.in[0]; F.c = args.in[1]; F.w_ada = args.in[2]; F.b_ada = args.in[3]; F.norm1_g = args.in[4]; F.w_in = args.in[5]; F.fox_q_norm = args.in[6]; F.fox_k_norm = args.in[7];
    F.fox_f_bias = args.in[8]; F.gdn_conv_w = args.in[9]; F.gdn_a_log = args.in[10]; F.gdn_dt_bias = args.in[11]; F.gdn_norm_w = args.in[12]; F.w_out = args.in[13]; F.norm2_g = args.in[14];
    F.w_gate = args.in[15]; F.w_up = args.in[16]; F.w_down = args.in[17]; F.out = args.out;
    for (int u = F.tid; u < (LDS_BYTES - LDSCTL_OFF) / 4; u += NWAVES * 64) ((LAS unsigned*)(F.lds + LDSCTL_OFF))[u] = 0u;
    __syncthreads();
    const int lo = args.ph_lo, hi = args.ph_hi;
    const bool fusedrun = (hi - lo) > 1;
    XcdBarrier bar; bar.bar = (unsigned*)(F.ctl + CW_BAR); bar.x = 0; bar.st = nullptr;
    if (fusedrun) bar = xcd_barrier_post((unsigned*)(F.ctl + CW_BAR), F.MISC + 8);
#ifndef PHASE_MASK
#define PHASE_MASK 0xfff
#endif
#define IN(k) (((PHASE_MASK >> (k)) & 1) && lo <= (k) && (k) < hi)
#define REFRESH() do { int t_ = threadIdx.x; asm volatile("" : "+v"(t_)); F.tid = t_; F.lane = t_ & 63; F.wave = __builtin_amdgcn_readfirstlane(t_ >> 6); } while (0)
#define SEAM(k) do { if (IN(k) && IN((k) + 1)) xcd_barrier(bar); } while (0)
    bf16* H = (bf16*)(args.ws + WS_H); bf16* P = (bf16*)(args.ws + WS_P); bf16* MIX = (bf16*)(args.ws + WS_MIX); bf16* HID = (bf16*)(args.ws + WS_HID); bf16* X1 = (bf16*)(args.ws + WS_X1);
    const float* MOD = (const float*)(args.ws + WS_MOD);

#ifndef REP_MASK
#define REP_MASK 0
#endif
#ifndef REPN
#define REPN 1
#endif
#define REP(k) (((REP_MASK >> (k)) & 1) && fusedrun)
#ifndef PRE_EPI
#define PRE_EPI EpiBf16<0>
#define PRE_EPI_INIT {P, NPP, nullptr, 0, 0, 1.f}
#endif
#ifndef PRE_K
#define PRE_K 0
#endif
#ifndef PRE_K10
#define PRE_K10 0
#endif
#ifndef SIDE_REP
#define SIDE_REP 1
#endif
#define LATE_OK ((int)F.G >= BATCH * NH + P6_CONV_WGS + P6_ADA_WGS)
#define PH0 { p0_ada<false>(F, 0, LATE_OK ? 2 * (DM / 256) : NMOD / 256, F.vcu, F.G); p0_weights<false>(F, 0, LATE_OK ? P0_ITEMS_IN : P0_ITEMS_ALL - P0_ITEMS_DOWN, F.vcu, F.G); }
#define PH1 { p1_modreduce(F, 0, LATE_OK ? 2 * DM : NMOD); }
#define PH2 { norm_mod_stage(F, F.norm1_g, 0, 1); REFRESH(); norm_mod_rows(F, F.x, LDH); }
#define PH3 { if (PRE_K > 0) { pg8::Gemm g{H, (const bf16*)(args.ws + WS_WIN), M, NP, PRE_K, LDH}; pg8::StaticOrder S; S.init(M, NP, F.G, (int)blockIdx.x); pg8::PRE_EPI E PRE_EPI_INIT; \
              pg8::gemm_phase<pg8::PRE_EPI, pg8::StaticOrder, PG8_ALIGN, PG8_SP2>(F.lds + RING_OFF, g, S, E); __syncthreads(); REFRESH(); } \
              { pg8::Gemm g{H, (const bf16*)(args.ws + WS_WIN), M, NP, DM, LDH}; pg8::StaticOrder S; S.init(M, NP, F.G, (int)blockIdx.x); pg8::EpiBf16QKL E{P, NPP, F.fox_q_norm, F.fox_k_norm, (LAS float*)(F.lds + RING_OFF + RING_BYTES)}; \
              pg8::gemm_phase<pg8::EpiBf16QKL, pg8::StaticOrder, PG8_ALIGN, PG8_SP2>(F.lds + RING_OFF, g, S, E); }                       \
              for (int r_ = 0; r_ < SIDE_REP; ++r_) { __syncthreads(); REFRESH(); \
              { pg8::Gemm g{H, (const bf16*)(args.ws + WS_WIN) + (size_t)NP * LDWIN, 8 * M, 512, DM / 8, DM / 8}; pg8::StaticOrder S; S.init(8 * M, 512, F.G, (int)blockIdx.x); pg8::EpiScalars E{(float*)(args.ws + WS_FLS), (float*)(args.ws + WS_GG), (float*)(args.ws + WS_GB), F.fox_f_bias, F.gdn_a_log, F.gdn_dt_bias, SEQ, NH}; \
              pg8::gemm_phase<pg8::EpiScalars, pg8::StaticOrder, PG8_ALIGN, PG8_SP2>(F.lds + RING_OFF, g, S, E); } } }
#define PH4 { }
#define PH5 { p5_kx(F); gdn_chunk_prep(F); }
#define PH6 { if (blockIdx.x < BATCH * NH) { gdn_scan(F, (int)blockIdx.x); VM_WAIT(); __syncthreads(); if (REP(12)) { REFRESH(); gdn_scan(F, (int)blockIdx.x); VM_WAIT(); __syncthreads(); } REFRESH(); } \
              else if (!LATE_OK) { } \
              else if ((int)blockIdx.x >= BATCH * NH + P6_CONV_WGS && (int)blockIdx.x < BATCH * NH + P6_CONV_WGS + P6_ADA_WGS) { p0_ada<true>(F, 2 * (DM / 256), NMOD / 256, (int)blockIdx.x - BATCH * NH - P6_CONV_WGS, P6_ADA_WGS); VM_WAIT(); __syncthreads(); REFRESH(); } \
              else if ((int)blockIdx.x < BATCH * NH + P6_CONV_WGS) { p0_weights<true>(F, P0_ITEMS_IN, P0_ITEMS_ALL - P0_ITEMS_DOWN, (int)blockIdx.x - BATCH * NH, P6_CONV_WGS); VM_WAIT(); __syncthreads(); REFRESH(); } \
              p5_fox(F, (char*)lds + RING_OFF); }
#define PH7 { if (LATE_OK) p1_modreduce(F, 2 * DM, NMOD); p6_gdn_out(F); }
#define PH8 { pg8::Gemm g{MIX, (const bf16*)(args.ws + WS_WOUT), M, DM, DM, LDMIX}; pg8::StaticOrder S; S.init(M, DM, F.G, (int)blockIdx.x); pg8::EpiResGateToBf16 E{F.x, X1, DM, MOD + 2 * DM, NMOD, SEQ}; \
              pg8::gemm_phase<pg8::EpiResGateToBf16, pg8::StaticOrder, PG8_ALIGN, PG8_SP2>(F.lds + RING_OFF, g, S, E); }
#define PH9 { norm_mod_stage(F, F.norm2_g, 3, 4); REFRESH(); norm_mod_rows_b16(F, X1, LDH2); }
#define PH10 { if (PRE_K10 > 0) { pg8::Gemm g{H, (const bf16*)(args.ws + WS_WGU), M, 2 * FF, PRE_K10, LDH2}; pg8::StaticOrder S; S.init(M, 2 * FF, F.G, (int)blockIdx.x); pg8::EpiSwiGLU E{HID, FF}; \
               pg8::gemm_phase<pg8::EpiSwiGLU, pg8::StaticOrder, PG8_ALIGN, PG8_SP2>(F.lds + RING_OFF, g, S, E); __syncthreads(); REFRESH(); } \
                pg8::Gemm g{H, (const bf16*)(args.ws + WS_WGU), M, 2 * FF, DM, LDH2}; pg8::StaticOrder S; S.init(M, 2 * FF, F.G, (int)blockIdx.x); pg8::EpiSwiGLU E{HID, FF}; \
               pg8::gemm_phase<pg8::EpiSwiGLU, pg8::StaticOrder, PG8_ALIGN, PG8_SP2>(F.lds + RING_OFF, g, S, E); \
               { const int nwg_ = (M / 256) * (2 * FF / 256), rem_ = nwg_ % F.G;            \
                 if ((int)blockIdx.x >= rem_) { REFRESH(); p0_weights<true>(F, P0_ITEMS_ALL - P0_ITEMS_DOWN, P0_ITEMS_ALL, (int)blockIdx.x - rem_, F.G - rem_); } } }
#define PH11 { pg8::Gemm g{HID, (const bf16*)(args.ws + WS_WD), M, DM, FF, FF}; pg8::StaticOrder S; S.init(M, DM, F.G, (int)blockIdx.x); pg8::EpiResGateFromBf16 E{X1, F.out, DM, MOD + 5 * DM, NMOD, SEQ}; \
               pg8::gemm_phase<pg8::EpiResGateFromBf16, pg8::StaticOrder, PG8_ALIGN, PG8_SP2>(F.lds + RING_OFF, g, S, E); }
#define PHASE(k, BODY) if (IN(k)) { REFRESH(); BODY if (REP(k)) { for (int rep_ = 0; rep_ < REPN; ++rep_) { xcd_barrier(bar); REFRESH(); BODY } } SEAM(k); }
    PHASE(0, PH0) PHASE(1, PH1) PHASE(2, PH2)
    if (IN(3)) { REFRESH(); PH3 if (REP(3)) { for (int rep_ = 0; rep_ < REPN; ++rep_) { xcd_barrier(bar); REFRESH(); PH3 } } if (IN(5)) xcd_barrier(bar); }
    PHASE(5, PH5) PHASE(6, PH6) PHASE(7, PH7) PHASE(8, PH8) PHASE(9, PH9) PHASE(10, PH10)
    if (IN(11)) { REFRESH(); PH11 }
#undef IN
#undef REFRESH
#undef SEAM
}

extern "C" void kernel_launch(void* const* d_in, const int* in_sizes, int n_in, void* d_out, int out_size, void* d_ws, size_t ws_size, hipStream_t stream) {
    static int grid = 0;
    if (grid == 0) {
        if (n_in != 18 || in_sizes[0] != M * DM || out_size != M * DM || ws_size < WS_END) { fprintf(stderr, "kernel_launch: shape/workspace mismatch (n_in %d, in0 %d, out %d, ws %zu < %zu); nothing launched\n", n_in, n_in > 0 ? in_sizes[0] : -1, out_size, ws_size, (size_t)WS_END); grid = -1; return; }
        int dev = 0, cus = 0, per_cu = 0;
        if (hipGetDevice(&dev) != hipSuccess || hipDeviceGetAttribute(&cus, hipDeviceAttributeMultiprocessorCount, dev) != hipSuccess) { grid = -1; return; }
        if (hipFuncSetAttribute((const void*)hyb_fwd, hipFuncAttributeMaxDynamicSharedMemorySize, LDS_BYTES) != hipSuccess) { fprintf(stderr, "kernel_launch: hipFuncSetAttribute failed\n"); grid = -1; return; }
        if (hipOccupancyMaxActiveBlocksPerMultiprocessor(&per_cu, (const void*)hyb_fwd, NWAVES * 64, LDS_BYTES) != hipSuccess || per_cu < 1)
            fprintf(stderr, "kernel_launch: note: occupancy query reports %d workgroups per CU\n", per_cu);
        (void)hipGetLastError();
        grid = cus;
    }
    if (grid < 0) return;
    if (hipMemsetAsync((char*)d_ws + WS_CTL, 0, CTL_ZERO_BYTES, stream) != hipSuccess) { fprintf(stderr, "kernel_launch: hipMemsetAsync failed\n"); return; }
    Args a{};
    for (int i = 0; i < 18; ++i) a.in[i] = (const float*)d_in[i];
    a.out = (float*)d_out; a.ws = (unsigned char*)d_ws;
#if MK_ONE_LAUNCH
    a.ph_lo = 0; a.ph_hi = N_PHASES;
    hipLaunchKernelGGL(hyb_fwd, dim3(grid), dim3(NWAVES * 64), LDS_BYTES, stream, a);
#else
    for (int ph = 0; ph < N_PHASES; ++ph) {
        a.ph_lo = ph; a.ph_hi = ph + 1;
        hipLaunchKernelGGL(hyb_fwd, dim3(grid), dim3(NWAVES * 64), LDS_BYTES, stream, a);
    }
#endif
    const hipError_t le = hipPeekAtLastError();
    if (le != hipSuccess) fprintf(stderr, "kernel_launch: launch failed: %s\n", hipGetErrorName(le));
}
```

```cpp
#include <hip/hip_runtime.h>
#include <cstdio>
#include <cstdint>
namespace pg8 {
#define PG8_LAS __attribute__((address_space(3)))
typedef unsigned short bf16_t;
typedef short bf16x8 __attribute__((ext_vector_type(8)));
typedef float f32x4 __attribute__((ext_vector_type(4)));
typedef unsigned u32x4 __attribute__((ext_vector_type(4)));
constexpr int BM = 256, BK = 64, HALF = 128, HTB = HALF * BK * 2  , STAGE_BYTES = 8 * HTB, NXCD = 8, WGM = 8;

__host__ __device__ __forceinline__ int lds_byte(int r, int c) { const int st = (r >> 4) * 2 + (c >> 5), rr = r & 15, cc = c & 31, ob = rr * 64 + cc * 2; return st * 1024 + (ob ^ (((ob >> 9) & 1) << 5)); }
__host__ __device__ __forceinline__ void stage_rc(int b, int& R, int& C) { const int st = b / 1024, sb = b % 1024, swz = sb ^ (((sb >> 9) & 1) << 5); R = (st >> 1) * 16 + swz / 64; C = (st & 1) * 32 + (swz % 64) / 2; }
__host__ __device__ __forceinline__ int perm32(int rho) { const int n = rho >> 4, i = rho & 15; return 8 * (i >> 2) + 4 * n + (i & 3); }

struct Unit { int pm, pn; };
struct Gemm { const bf16_t* A; const bf16_t* Bt; int M, N, K, ld; };

struct StaticOrder {
    int nM, nN, nwg, G, c;
    __host__ __device__ void init(int M, int N, int G_, int c_) { nM = M / BM; nN = N / BM; nwg = nM * nN; G = G_; c = c_; }
    __host__ __device__ bool next(int i, Unit& u) const {
        const long L = (long)i * G + c; if (L >= nwg) return false;
        int wgid = (int)L; { const int q = nwg / NXCD, r = nwg % NXCD, xcd = wgid % NXCD, off = wgid / NXCD; wgid = (xcd < r ? xcd * (q + 1) : r * (q + 1) + (xcd - r) * q) + off; }
        const int nig = WGM * nN, gid = wgid / nig, fm = gid * WGM, gsz = (nM - fm) < WGM ? (nM - fm) : WGM;
        u.pm = fm + ((wgid % nig) % gsz); u.pn = (wgid % nig) / gsz; return true;
    }
    __device__ __forceinline__ void a_ready(const Unit&) const {}
    __device__ __forceinline__ void done(const Unit&) const {}
};

__device__ __forceinline__ unsigned cvt_pk_bf16(float lo, float hi) { unsigned r; asm volatile("v_cvt_pk_bf16_f32 %0, %1, %2" : "=v"(r) : "v"(lo), "v"(hi)); return r; }
typedef float f32x2 __attribute__((ext_vector_type(2)));
__device__ __forceinline__ f32x2 gelu_pk(f32x2 v) {
    const f32x2 av = __builtin_elementwise_abs(v), d = av * 0.2316418882f + 1.0f;
    f32x2 t; t.x = __builtin_amdgcn_rcpf(d.x); t.y = __builtin_amdgcn_rcpf(d.y);
    f32x2 q = t * 0.5307027145f + (-0.7265760135f); q = q * t + 0.7107068705f; q = q * t + (-0.142248368f); q = q * t + 0.127414796f; q = q * t;
    const f32x2 s = (v * v) * (-0.72134752044f);
    f32x2 e; e.x = __builtin_amdgcn_exp2f(s.x); e.y = __builtin_amdgcn_exp2f(s.y);
    const f32x2 m = v * (q * e), r = v - m;
    f32x2 o; o.x = v.x < 0.f ? m.x : r.x; o.y = v.y < 0.f ? m.y : r.y; return o;
}

template <int ACT  > struct EpiBf16 {
    static constexpr bool PERM = true, AFTER_DRAIN = false; static_assert(ACT == 0 || ACT == 1, "EpiBf16: ACT is 0 (none) or 1 (gelu_pk)");
    bf16_t* O; int ldc; const float* bias; int split_cols; size_t split_stride; float scale0;
    __device__ __forceinline__ void operator()(const f32x4 (&acc)[2][2][4][2], const Unit& u, int wr, int wc, int fr, int fq) const {
        const int row0 = u.pm * BM + wr * 64 + fr; int colt = u.pn * BM; bf16_t* base = O;
        float sc = 1.f; if (split_cols) { const int t = colt / split_cols; base += (size_t)t * split_stride; colt -= t * split_cols; if (t == 0) sc = scale0; }
        const int col0 = colt + wc * 32 + 8 * fq, bcol0 = u.pn * BM + wc * 32 + 8 * fq;
        f32x4 bv[2][2];
#pragma unroll
        for (int bj = 0; bj < 2; ++bj)
#pragma unroll
            for (int n = 0; n < 2; ++n) bv[bj][n] = bias ? *(const f32x4*)(bias + bcol0 + bj * HALF + 4 * n) : (f32x4){0.f, 0.f, 0.f, 0.f};
#pragma unroll
        for (int ai = 0; ai < 2; ++ai)
#pragma unroll
            for (int m = 0; m < 4; ++m) { bf16_t* rowp = base + (size_t)(row0 + ai * HALF + m * 16) * ldc + col0;
#pragma unroll
                for (int bj = 0; bj < 2; ++bj) { f32x4 v0 = acc[ai][bj][m][0] + bv[bj][0], v1 = acc[ai][bj][m][1] + bv[bj][1];
                    if (ACT == 1) { f32x2 a = gelu_pk((f32x2){v0[0], v0[1]}), b = gelu_pk((f32x2){v0[2], v0[3]}), c = gelu_pk((f32x2){v1[0], v1[1]}), d = gelu_pk((f32x2){v1[2], v1[3]});
                        v0 = (f32x4){a.x, a.y, b.x, b.y}; v1 = (f32x4){c.x, c.y, d.x, d.y}; }
                    v0 = v0 * sc; v1 = v1 * sc; u32x4 w; w.x = cvt_pk_bf16(v0[0], v0[1]); w.y = cvt_pk_bf16(v0[2], v0[3]); w.z = cvt_pk_bf16(v1[0], v1[1]); w.w = cvt_pk_bf16(v1[2], v1[3]);
                    *(u32x4*)(rowp + bj * HALF) = w; } }
    }
};

struct EpiResGate {
    static constexpr bool PERM = false, AFTER_DRAIN = false;
    const float* base; float* out; int ldc; const float* gate; int gate_stride; int rows_per_batch;
    __device__ __forceinline__ void operator()(const f32x4 (&acc)[2][2][4][2], const Unit& u, int wr, int wc, int fr, int fq) const {
        const int col0 = u.pn * BM + wc * 32 + 4 * fq;
        const int b = (u.pm * BM) / rows_per_batch;
        const float* gp = gate + (size_t)b * gate_stride + col0;
        f32x4 gv[2][2];
#pragma unroll
        for (int bj = 0; bj < 2; ++bj)
#pragma unroll
            for (int n = 0; n < 2; ++n) gv[bj][n] = *(const f32x4*)(gp + bj * HALF + n * 16);
        const size_t row0 = (size_t)(u.pm * BM + wr * 64 + fr) * ldc + col0;
        f32x4 bs[2][2][2];
#pragma unroll
        for (int bj = 0; bj < 2; ++bj)
#pragma unroll
            for (int n = 0; n < 2; ++n) bs[0][bj][n] = *(const f32x4*)(base + row0 + bj * HALF + n * 16);
#pragma unroll
        for (int g = 0; g < 8; ++g) { const int ai = g >> 2, m = g & 3; const size_t off = row0 + (size_t)(ai * HALF + m * 16) * ldc;
            if (g < 7) { const size_t offn = row0 + (size_t)(((g + 1) >> 2) * HALF + ((g + 1) & 3) * 16) * ldc;
#pragma unroll
                for (int bj = 0; bj < 2; ++bj)
#pragma unroll
                    for (int n = 0; n < 2; ++n) bs[(g + 1) & 1][bj][n] = *(const f32x4*)(base + offn + bj * HALF + n * 16); }
#pragma unroll
            for (int bj = 0; bj < 2; ++bj)
#pragma unroll
                for (int n = 0; n < 2; ++n) *(f32x4*)(out + off + bj * HALF + n * 16) = bs[g & 1][bj][n] + gv[bj][n] * acc[ai][bj][m][n];
        }
    }
};
struct EpiSwiGLU {
    static constexpr bool PERM = true, AFTER_DRAIN = false;
    bf16_t* O; int ldo;
    __device__ __forceinline__ static float silu_mul(float g, float u) { return g * __builtin_amdgcn_rcpf(1.0f + __builtin_amdgcn_exp2f(-1.4426950408889634f * g)) * u; }
    __device__ __forceinline__ void operator()(const f32x4 (&acc)[2][2][4][2], const Unit& u, int wr, int wc, int fr, int fq) const {
        const int row0 = u.pm * BM + wr * 64 + fr, col0 = u.pn * HALF + wc * 32 + 8 * fq;
#pragma unroll
        for (int ai = 0; ai < 2; ++ai)
#pragma unroll
            for (int m = 0; m < 4; ++m) { bf16_t* rowp = O + (size_t)(row0 + ai * HALF + m * 16) * ldo + col0;
                const f32x4 g0 = acc[ai][0][m][0], g1 = acc[ai][0][m][1], u0 = acc[ai][1][m][0], u1 = acc[ai][1][m][1];
                u32x4 w;
                w.x = cvt_pk_bf16(silu_mul(g0[0], u0[0]), silu_mul(g0[1], u0[1])); w.y = cvt_pk_bf16(silu_mul(g0[2], u0[2]), silu_mul(g0[3], u0[3]));
                w.z = cvt_pk_bf16(silu_mul(g1[0], u1[0]), silu_mul(g1[1], u1[1])); w.w = cvt_pk_bf16(silu_mul(g1[2], u1[2]), silu_mul(g1[3], u1[3]));
                *(u32x4*)rowp = w; }
    }
};
struct EpiSplit {
    static constexpr bool PERM = false, AFTER_DRAIN = false;
    float* SP; int rows;
    __device__ __forceinline__ void operator()(const f32x4 (&acc)[2][2][4][2], const Unit& u, int wr, int wc, int fr, int fq) const {
        if ((((fr >> 2) ^ fq) & 1) != 0) return;
        const int ks = fr & 7, e = fr & 3;
        float* base = SP + (size_t)ks * rows * 64;
#pragma unroll
        for (int ai = 0; ai < 2; ++ai)
#pragma unroll
            for (int m = 0; m < 4; ++m) { const int row_o = 32 * u.pm + 16 * ai + 8 * wr + 2 * m + (fr >> 3);
#pragma unroll
                for (int bj = 0; bj < 2; ++bj)
#pragma unroll
                    for (int n = 0; n < 2; ++n) { const int col_o = 32 * u.pn + 16 * bj + 4 * wc + 2 * n + (fq >> 1);
                        const f32x4 v = acc[ai][bj][m][n];
                        base[(size_t)row_o * 64 + col_o] = e == 0 ? v[0] : (e == 1 ? v[1] : (e == 2 ? v[2] : v[3])); } }
    }
};
struct EpiResGateToBf16 {
    static constexpr bool PERM = true, AFTER_DRAIN = false;
    const float* base; bf16_t* out; int ldc; const float* gate; int gate_stride; int rows_per_batch;
    __device__ __forceinline__ void operator()(const f32x4 (&acc)[2][2][4][2], const Unit& u, int wr, int wc, int fr, int fq) const {
        const int col0 = u.pn * BM + wc * 32 + 8 * fq;
        const int b = (u.pm * BM) / rows_per_batch;
        const float* gp = gate + (size_t)b * gate_stride + col0;
        f32x4 gv[2][2];
#pragma unroll
        for (int bj = 0; bj < 2; ++bj)
#pragma unroll
            for (int n = 0; n < 2; ++n) gv[bj][n] = *(const f32x4*)(gp + bj * HALF + 4 * n);
        const size_t row0 = (size_t)(u.pm * BM + wr * 64 + fr) * ldc + col0;
        f32x4 bs[2][2][2];
#pragma unroll
        for (int bj = 0; bj < 2; ++bj)
#pragma unroll
            for (int n = 0; n < 2; ++n) bs[0][bj][n] = *(const f32x4*)(base + row0 + bj * HALF + 4 * n);
#pragma unroll
        for (int g = 0; g < 8; ++g) { const int ai = g >> 2, m = g & 3; const size_t off = row0 + (size_t)(ai * HALF + m * 16) * ldc;
            if (g < 7) { const size_t offn = row0 + (size_t)(((g + 1) >> 2) * HALF + ((g + 1) & 3) * 16) * ldc;
#pragma unroll
                for (int bj = 0; bj < 2; ++bj)
#pragma unroll
                    for (int n = 0; n < 2; ++n) bs[(g + 1) & 1][bj][n] = *(const f32x4*)(base + offn + bj * HALF + 4 * n); }
#pragma unroll
            for (int bj = 0; bj < 2; ++bj) { const f32x4 v0 = bs[g & 1][bj][0] + gv[bj][0] * acc[ai][bj][m][0], v1 = bs[g & 1][bj][1] + gv[bj][1] * acc[ai][bj][m][1];
                u32x4 w; w.x = cvt_pk_bf16(v0[0], v0[1]); w.y = cvt_pk_bf16(v0[2], v0[3]); w.z = cvt_pk_bf16(v1[0], v1[1]); w.w = cvt_pk_bf16(v1[2], v1[3]);
                *(u32x4*)(out + off + bj * HALF) = w; }
        }
    }
};
struct EpiResGateFromBf16 {
    static constexpr bool PERM = true, AFTER_DRAIN = false;
    const bf16_t* base; float* out; int ldc; const float* gate; int gate_stride; int rows_per_batch;
    __device__ __forceinline__ void operator()(const f32x4 (&acc)[2][2][4][2], const Unit& u, int wr, int wc, int fr, int fq) const {
        const int col0 = u.pn * BM + wc * 32 + 8 * fq;
        const int b = (u.pm * BM) / rows_per_batch;
        const float* gp = gate + (size_t)b * gate_stride + col0;
        f32x4 gv[2][2];
#pragma unroll
        for (int bj = 0; bj < 2; ++bj)
#pragma unroll
            for (int n = 0; n < 2; ++n) gv[bj][n] = *(const f32x4*)(gp + bj * HALF + 4 * n);
        const size_t row0 = (size_t)(u.pm * BM + wr * 64 + fr) * ldc + col0;
        u32x4 bs[2][2];
#pragma unroll
        for (int bj = 0; bj < 2; ++bj) bs[0][bj] = *(const u32x4*)(base + row0 + bj * HALF);
#pragma unroll
        for (int g = 0; g < 8; ++g) { const int ai = g >> 2, m = g & 3; const size_t off = row0 + (size_t)(ai * HALF + m * 16) * ldc;
            if (g < 7) { const size_t offn = row0 + (size_t)(((g + 1) >> 2) * HALF + ((g + 1) & 3) * 16) * ldc;
#pragma unroll
                for (int bj = 0; bj < 2; ++bj) bs[(g + 1) & 1][bj] = *(const u32x4*)(base + offn + bj * HALF); }
#pragma unroll
            for (int bj = 0; bj < 2; ++bj) { const u32x4 w = bs[g & 1][bj];
                const f32x4 x0 = {__builtin_bit_cast(float, w.x << 16), __builtin_bit_cast(float, w.x & 0xffff0000u), __builtin_bit_cast(float, w.y << 16), __builtin_bit_cast(float, w.y & 0xffff0000u)};
                const f32x4 x1 = {__builtin_bit_cast(float, w.z << 16), __builtin_bit_cast(float, w.z & 0xffff0000u), __builtin_bit_cast(float, w.w << 16), __builtin_bit_cast(float, w.w & 0xffff0000u)};
                *(f32x4*)(out + off + bj * HALF) = x0 + gv[bj][0] * acc[ai][bj][m][0];
                *(f32x4*)(out + off + bj * HALF + 4) = x1 + gv[bj][1] * acc[ai][bj][m][1]; }
        }
    }
};
struct EpiBf16QK {
    static constexpr bool PERM = true, AFTER_DRAIN = false;
    bf16_t* O; int ldc; const float* qg; const float* kg; PG8_LAS float* part;
    __device__ __forceinline__ void operator()(const f32x4 (&acc)[2][2][4][2], const Unit& u, int wr, int wc, int fr, int fq) const {
        const int row0 = u.pm * BM + wr * 64 + fr, col0 = u.pn * BM + wc * 32 + 8 * fq;
        const bool normed = u.pn < 16;
        f32x4 g0 = {1.f, 1.f, 1.f, 1.f}, g1 = g0;
        if (normed) {
            const float* gp = (u.pn < 8 ? qg : kg) + wc * 32 + 8 * fq; g0 = *(const f32x4*)gp; g1 = *(const f32x4*)(gp + 4);
#pragma unroll
            for (int ai = 0; ai < 2; ++ai)
#pragma unroll
                for (int m = 0; m < 4; ++m)
#pragma unroll
                    for (int bj = 0; bj < 2; ++bj) { const f32x4 v0 = acc[ai][bj][m][0], v1 = acc[ai][bj][m][1];
                        float ss = ((v0[0] * v0[0] + v0[1] * v0[1]) + (v0[2] * v0[2] + v0[3] * v0[3])) + ((v1[0] * v1[0] + v1[1] * v1[1]) + (v1[2] * v1[2] + v1[3] * v1[3]));
                        ss += __shfl_xor(ss, 16); ss += __shfl_xor(ss, 32);
                        if (fq == 0) part[((ai * HALF + wr * 64 + m * 16 + fr) * 2 + bj) * 4 + wc] = ss; }
            asm volatile("s_waitcnt lgkmcnt(0)" ::: "memory"); __builtin_amdgcn_s_barrier(); asm volatile("" ::: "memory");
        }
#pragma unroll
        for (int ai = 0; ai < 2; ++ai)
#pragma unroll
            for (int m = 0; m < 4; ++m) { bf16_t* rowp = O + (size_t)(row0 + ai * HALF + m * 16) * ldc + col0;
#pragma unroll
                for (int bj = 0; bj < 2; ++bj) { f32x4 v0 = acc[ai][bj][m][0] + 0.f, v1 = acc[ai][bj][m][1] + 0.f;
                    if (normed) { const f32x4 p = *(const PG8_LAS f32x4*)(part + ((ai * HALF + wr * 64 + m * 16 + fr) * 2 + bj) * 4);
                        const float rstd = 1.0f / sqrtf(((p[0] + p[1]) + (p[2] + p[3])) * (1.0f / 128.0f) + 1e-6f);
                        v0 = v0 * rstd * g0; v1 = v1 * rstd * g1; }
                    u32x4 w; w.x = cvt_pk_bf16(v0[0], v0[1]); w.y = cvt_pk_bf16(v0[2], v0[3]); w.z = cvt_pk_bf16(v1[0], v1[1]); w.w = cvt_pk_bf16(v1[2], v1[3]);
                    *(u32x4*)(rowp + bj * HALF) = w; } }
    }
};
struct EpiBf16QKL {
    static constexpr bool PERM = true, AFTER_DRAIN = false, BADJ = true;
    bf16_t* O; int ldc; const float* qg; const float* kg; PG8_LAS float* part;
    __device__ __forceinline__ void operator()(const f32x4 (&acc)[2][2][4][2], const Unit& u, int wr, int wc, int fr, int fq) const {
        const bool normed = u.pn < 16, lo = fr < 8;
        f32x4 g[2][2];
#pragma unroll
        for (int bj = 0; bj < 2; ++bj)
#pragma unroll
            for (int n = 0; n < 2; ++n) g[bj][n] = (f32x4){1.f, 1.f, 1.f, 1.f};
        if (normed) {
            const float* gp = (u.pn < 8 ? qg : kg) + (wc & 1) * 64 + 8 * fq;
#pragma unroll
            for (int bj = 0; bj < 2; ++bj)
#pragma unroll
                for (int n = 0; n < 2; ++n) g[bj][n] = *(const f32x4*)(gp + bj * 32 + 4 * n);
#pragma unroll
            for (int ai = 0; ai < 2; ++ai)
#pragma unroll
                for (int m = 0; m < 4; ++m) { float ss = 0.f;
                    { const f32x4 a0 = acc[ai][0][m][0], a1 = acc[ai][0][m][1], b0 = acc[ai][1][m][0], b1 = acc[ai][1][m][1];
                      ss = (((a0[0] * a0[0] + a0[1] * a0[1]) + (a0[2] * a0[2] + a0[3] * a0[3])) + ((a1[0] * a1[0] + a1[1] * a1[1]) + (a1[2] * a1[2] + a1[3] * a1[3])))
                         + (((b0[0] * b0[0] + b0[1] * b0[1]) + (b0[2] * b0[2] + b0[3] * b0[3])) + ((b1[0] * b1[0] + b1[1] * b1[1]) + (b1[2] * b1[2] + b1[3] * b1[3]))); }
                    ss += __shfl_xor(ss, 16); ss += __shfl_xor(ss, 32);
                    if (fq == 0) part[(ai * HALF + wr * 64 + m * 16 + fr) * 4 + wc] = ss; }
            asm volatile("s_waitcnt lgkmcnt(0)" ::: "memory"); __builtin_amdgcn_s_barrier(); asm volatile("" ::: "memory");
        }
        bf16_t* base = O + (size_t)(u.pm * BM + wr * 64 + (fr & 7)) * ldc + u.pn * BM + wc * 64 + (lo ? 0 : 32) + 8 * fq;
#pragma unroll
        for (int ai = 0; ai < 2; ++ai)
#pragma unroll
            for (int m = 0; m < 4; ++m) {
                float rstd = 1.f;
                if (normed) { const PG8_LAS float* p = part + (ai * HALF + wr * 64 + m * 16 + fr) * 4 + (wc & 2); rstd = 1.0f / sqrtf((p[0] + p[1]) * (1.0f / 128.0f) + 1e-6f); }
                u32x4 w[2];
#pragma unroll
                for (int bj = 0; bj < 2; ++bj) { const f32x4 v0 = acc[ai][bj][m][0] * rstd * g[bj][0], v1 = acc[ai][bj][m][1] * rstd * g[bj][1];
                    w[bj].x = cvt_pk_bf16(v0[0], v0[1]); w[bj].y = cvt_pk_bf16(v0[2], v0[3]); w[bj].z = cvt_pk_bf16(v1[0], v1[1]); w[bj].w = cvt_pk_bf16(v1[2], v1[3]); }
                const u32x4 snd = lo ? w[1] : w[0];
                u32x4 rcv; rcv.x = __shfl_xor(snd.x, 8); rcv.y = __shfl_xor(snd.y, 8); rcv.z = __shfl_xor(snd.z, 8); rcv.w = __shfl_xor(snd.w, 8);
                bf16_t* rp = base + (size_t)(ai * HALF + m * 16) * ldc;
                *(u32x4*)rp = lo ? w[0] : rcv;
                *(u32x4*)(rp + (size_t)8 * ldc) = lo ? rcv : w[1];
                asm volatile("" ::: "memory");
            }
    }
};
struct EpiScalars {
    static constexpr bool PERM = false, AFTER_DRAIN = false;
    float* FLS; float* GG; float* GB; const float* f_bias; const float* a_log; const float* dt_bias; int seq, nh;
    __device__ __forceinline__ void operator()(const f32x4 (&acc)[2][2][4][2], const Unit& u, int wr, int wc, int fr, int fq) const {
        const bool diag = (((fr >> 2) ^ fq) & 1) == 0;
        const int e = fr & 3, ks = fr & 7;
        float mine[4] = {0.f, 0.f, 0.f, 0.f};
#pragma unroll
        for (int ai = 0; ai < 2; ++ai)
#pragma unroll
            for (int m = 0; m < 4; ++m)
#pragma unroll
                for (int bj = 0; bj < 2; ++bj)
#pragma unroll
                    for (int n = 0; n < 2; ++n) { const f32x4 a4 = acc[ai][bj][m][n];
                        float v = diag ? (e == 0 ? a4[0] : (e == 1 ? a4[1] : (e == 2 ? a4[2] : a4[3]))) : 0.f;
                        v += __shfl_xor(v, 1); v += __shfl_xor(v, 2); v += __shfl_xor(v, 20);
                        if (ks == ai * 4 + m) mine[bj * 2 + n] = v; }
        if (!diag) return;
        const int row = 32 * u.pm + 16 * (ks >> 2) + 8 * wr + 2 * (ks & 3) + (fr >> 3), b = row / seq, t = row % seq;
#pragma unroll
        for (int j = 0; j < 4; ++j) { const int col = 32 * u.pn + 16 * (j >> 1) + 4 * wc + 2 * (j & 1) + (fq >> 1);
            if (col < 48) { const int h = col & 15; const size_t o = (size_t)(b * nh + h) * seq + t; const float v = mine[j];
                if (col < 16) { const float z = v + f_bias[h]; FLS[o] = (z < 0.f ? z : 0.f) - log1pf(expf(-fabsf(z))); }
                else if (col < 32) { const float xs = v + dt_bias[h]; const float sp_ = xs > 20.f ? xs : log1pf(expf(xs)); GG[o] = -expf(a_log[h]) * sp_; }
                else GB[o] = 1.0f / (1.0f + expf(-v)); } }
    }
};
struct EpiProbe {
    static constexpr bool PERM = true, AFTER_DRAIN = false;
    float* sink;
    __device__ __forceinline__ void operator()(const f32x4 (&acc)[2][2][4][2], const Unit& u, int wr, int wc, int fr, int fq) const {
        f32x4 s = {0.f, 0.f, 0.f, 0.f};
#pragma unroll
        for (int ai = 0; ai < 2; ++ai)
#pragma unroll
            for (int bj = 0; bj < 2; ++bj)
#pragma unroll
                for (int m = 0; m < 4; ++m)
#pragma unroll
                    for (int n = 0; n < 2; ++n) s += acc[ai][bj][m][n];
        const float t = (s.x + s.y) + (s.z + s.w);
        if (t == 12345.678f) sink[u.pm * 64 + u.pn] = t;
    }
};

template <class E, class = void> struct badj_of { static constexpr bool v = false; };
template <class E> struct badj_of<E, decltype((void)E::BADJ)> { static constexpr bool v = E::BADJ; };
template <class Epi, class Sched, bool ALIGN_EPI = false, bool SP2 = false>
__device__ __forceinline__ void gemm_phase(PG8_LAS unsigned char* lds, const Gemm g, const Sched& S, const Epi& E) {
    int tid_ = threadIdx.x; asm volatile("" : "+v"(tid_));
    const int tid = tid_, wid = __builtin_amdgcn_readfirstlane(tid >> 6), lane = tid & 63, wr = wid >> 2, wc = wid & 3, fr = lane & 15, fq = lane >> 4;
    const int K = g.ld, nt = g.K / BK;
    unsigned voffA[2], voffB[2];
    constexpr bool BADJ = badj_of<Epi>::v;
#pragma unroll
    for (int i = 0; i < 2; ++i) { int R, C; stage_rc(tid * 16 + i * 8192, R, C); const int Rb = BADJ ? ((R >> 5) * 64 + perm32(R & 31)) : (Epi::PERM ? ((R & ~31) + perm32(R & 31)) : R);
        voffA[i] = (unsigned)(R * K + C) * 2u; voffB[i] = (unsigned)(Rb * K + C) * 2u; }
    const size_t kstep = (size_t)(BK * 2);
    const size_t hstep = (size_t)HALF * K * 2;
    const size_t hstepB = BADJ ? (size_t)32 * K * 2 : hstep;
    const size_t tstep = 2 * hstep;
    const unsigned ldsw = (unsigned)wid * 1024u;
    const int aoff = lds_byte(wr * 64 + fr, fq * 8), boff = lds_byte(wc * 32 + fr, fq * 8);
#define PG8_SA(b, h) (((b) * 2 + (h)) * HTB)
#define PG8_SB(b, h) ((4 + (b) * 2 + (h)) * HTB)
#define PG8_STAGE(bufoff, gbase, voff) do { _Pragma("unroll") for (int _i = 0; _i < 2; ++_i) \
        __builtin_amdgcn_global_load_lds((const unsigned*)((const char*)(gbase) + (voff)[_i]), (PG8_LAS unsigned*)(lds + (bufoff) + ldsw + _i * 8192), 16, 0, 0); } while (0)
#define PG8_LDA(dst, b, h) do { _Pragma("unroll") for (int m = 0; m < 4; ++m) _Pragma("unroll") for (int k = 0; k < 2; ++k) dst[m][k] = *(const PG8_LAS bf16x8*)(lds + PG8_SA(b, h) + aoff + m * 2048 + k * 1024); } while (0)
#define PG8_LDB(dst, b, h) do { _Pragma("unroll") for (int n = 0; n < 2; ++n) _Pragma("unroll") for (int k = 0; k < 2; ++k) dst[n][k] = *(const PG8_LAS bf16x8*)(lds + PG8_SB(b, h) + boff + n * 2048 + k * 1024); } while (0)
#define PG8_MMA(ai, bj, At, Bt) do { __builtin_amdgcn_s_setprio(1); _Pragma("unroll") for (int m = 0; m < 4; ++m) _Pragma("unroll") for (int n = 0; n < 2; ++n) _Pragma("unroll") for (int k = 0; k < 2; ++k) \
        acc[ai][bj][m][n] = __builtin_amdgcn_mfma_f32_16x16x32_bf16(Bt[n][k], At[m][k], acc[ai][bj][m][n], 0, 0, 0); __builtin_amdgcn_s_setprio(0); } while (0)
#define PG8_WAIT_V(n) asm volatile("s_waitcnt vmcnt(" #n ")" ::: "memory")
#define PG8_WAIT_L(n) asm volatile("s_waitcnt lgkmcnt(" #n ")" ::: "memory")
#define PG8_BAR __builtin_amdgcn_s_barrier()
#define PG8_SCHED __builtin_amdgcn_sched_barrier(0)
    Unit cur, nxt; int ui = 0;
    if (!S.next(0, cur)) return;
    f32x4 acc[2][2][4][2];
#pragma unroll
    for (int a = 0; a < 2; ++a)
#pragma unroll
        for (int b = 0; b < 2; ++b)
#pragma unroll
            for (int m = 0; m < 4; ++m)
#pragma unroll
                for (int n = 0; n < 2; ++n) acc[a][b][m][n] = (f32x4){0.f, 0.f, 0.f, 0.f};
    bf16x8 At[4][2], B0[2][2], B1[2][2];
    const char* cA = (const char*)g.A + (size_t)cur.pm * tstep; const char* cB = (const char*)g.Bt + (size_t)cur.pn * tstep;
    S.a_ready(cur);
    if constexpr (SP2) {
        PG8_STAGE(PG8_SB(0, 0), cB, voffB); PG8_STAGE(PG8_SB(0, 1), cB + hstepB, voffB); PG8_STAGE(PG8_SA(0, 0), cA, voffA); PG8_STAGE(PG8_SA(0, 1), cA + hstep, voffA);
        if (wr == 1) PG8_BAR;
        PG8_WAIT_V(2); PG8_BAR;
        PG8_STAGE(PG8_SB(1, 0), cB + kstep, voffB); PG8_STAGE(PG8_SA(1, 0), cA + kstep, voffA); PG8_STAGE(PG8_SB(1, 1), cB + hstepB + kstep, voffB);
        PG8_WAIT_V(6); PG8_BAR;
    } else {
        PG8_STAGE(PG8_SB(0, 0), cB, voffB); PG8_STAGE(PG8_SA(0, 0), cA, voffA); PG8_STAGE(PG8_SB(0, 1), cB + hstepB, voffB); PG8_STAGE(PG8_SA(0, 1), cA + hstep, voffA);
        if (wr == 1) PG8_BAR;
        PG8_WAIT_V(4); PG8_BAR;
        PG8_STAGE(PG8_SB(1, 0), cB + kstep, voffB); PG8_STAGE(PG8_SA(1, 0), cA + kstep, voffA); PG8_STAGE(PG8_SB(1, 1), cB + hstepB + kstep, voffB);
        PG8_WAIT_V(6); PG8_BAR;
    }
    for (;;) {
        const bool has_next = S.next(ui + 1, nxt);
        const char* nA = has_next ? (const char*)g.A + (size_t)nxt.pm * tstep : cA; const char* nB = has_next ? (const char*)g.Bt + (size_t)nxt.pn * tstep : cB;
        for (int t = 0; t < nt; t += 2) {
            const bool last = (t == nt - 2);
            const char* a1 = cA + (size_t)(t + 1) * kstep;
            const char* a2 = last ? nA : cA + (size_t)(t + 2) * kstep; const char* b2 = last ? nB : cB + (size_t)(t + 2) * kstep;
            const char* a3 = a2 + kstep; const char* b3 = b2 + kstep;
            if (last && has_next) S.a_ready(nxt);
            if constexpr (SP2) {
            PG8_LDB(B0, 0, 0); PG8_LDB(B1, 0, 1); PG8_SCHED; PG8_LDA(At, 0, 0); PG8_STAGE(PG8_SA(1, 1), a1 + hstep, voffA);
            PG8_WAIT_V(8); PG8_WAIT_L(0); PG8_BAR; PG8_MMA(0, 0, At, B0); PG8_MMA(0, 1, At, B1); PG8_BAR; PG8_SCHED;
            PG8_LDA(At, 0, 1); PG8_STAGE(PG8_SB(0, 0), b2, voffB); PG8_STAGE(PG8_SB(0, 1), b2 + hstepB, voffB); PG8_STAGE(PG8_SA(0, 0), a2, voffA);
            PG8_WAIT_V(8); PG8_WAIT_L(0); PG8_BAR; PG8_MMA(1, 0, At, B0); PG8_MMA(1, 1, At, B1); PG8_BAR; PG8_SCHED;
            PG8_LDB(B0, 1, 0); PG8_LDB(B1, 1, 1); PG8_SCHED; PG8_LDA(At, 1, 0); PG8_STAGE(PG8_SA(0, 1), a2 + hstep, voffA);
            PG8_WAIT_V(8); PG8_WAIT_L(0); PG8_BAR; PG8_MMA(0, 0, At, B0); PG8_MMA(0, 1, At, B1); PG8_BAR; PG8_SCHED;
            PG8_LDA(At, 1, 1); PG8_STAGE(PG8_SB(1, 0), b3, voffB); PG8_STAGE(PG8_SB(1, 1), b3 + hstepB, voffB); PG8_STAGE(PG8_SA(1, 0), a3, voffA);
            PG8_WAIT_V(8); PG8_WAIT_L(0); PG8_BAR; PG8_MMA(1, 0, At, B0); PG8_MMA(1, 1, At, B1); PG8_BAR; PG8_SCHED;
            } else {
            PG8_LDB(B0, 0, 0); PG8_SCHED; PG8_LDA(At, 0, 0); PG8_STAGE(PG8_SA(1, 1), a1 + hstep, voffA);
            PG8_WAIT_L(8); PG8_BAR; PG8_WAIT_L(0); PG8_MMA(0, 0, At, B0); PG8_BAR; PG8_SCHED;
            PG8_LDB(B1, 0, 1); PG8_STAGE(PG8_SB(0, 0), b2, voffB);
            PG8_BAR; PG8_WAIT_L(0); PG8_MMA(0, 1, At, B1); PG8_BAR;
            PG8_LDA(At, 0, 1); PG8_STAGE(PG8_SA(0, 0), a2, voffA);
            PG8_BAR; PG8_WAIT_L(0); PG8_MMA(1, 0, At, B0); PG8_BAR; PG8_SCHED;
            PG8_STAGE(PG8_SB(0, 1), b2 + hstepB, voffB);
            PG8_WAIT_V(6); PG8_BAR; PG8_MMA(1, 1, At, B1); PG8_BAR;
            PG8_LDB(B0, 1, 0); PG8_SCHED; PG8_LDA(At, 1, 0); PG8_STAGE(PG8_SA(0, 1), a2 + hstep, voffA);
            PG8_WAIT_L(8); PG8_BAR; PG8_WAIT_L(0); PG8_MMA(0, 0, At, B0); PG8_BAR; PG8_SCHED;
            PG8_LDB(B1, 1, 1); PG8_STAGE(PG8_SB(1, 0), b3, voffB);
            PG8_BAR; PG8_WAIT_L(0); PG8_MMA(0, 1, At, B1); PG8_BAR;
            PG8_LDA(At, 1, 1); PG8_STAGE(PG8_SA(1, 0), a3, voffA);
            PG8_BAR; PG8_WAIT_L(0); PG8_MMA(1, 0, At, B0); PG8_BAR; PG8_SCHED;
            PG8_STAGE(PG8_SB(1, 1), b3 + hstepB, voffB);
            PG8_WAIT_V(6); PG8_BAR; PG8_MMA(1, 1, At, B1); PG8_BAR;
            }
        }
        if constexpr (ALIGN_EPI) { if (wr == 0) PG8_BAR; }
        if constexpr (!Epi::AFTER_DRAIN) { E(acc, cur, wr, wc, fr, fq); S.done(cur); }
        if (!has_next) break;
#pragma unroll
        for (int a = 0; a < 2; ++a)
#pragma unroll
            for (int b = 0; b < 2; ++b)
#pragma unroll
                for (int m = 0; m < 4; ++m)
#pragma unroll
                    for (int n = 0; n < 2; ++n) acc[a][b][m][n] = (f32x4){0.f, 0.f, 0.f, 0.f};
        cur = nxt; cA = nA; cB = nB; ++ui;
        if constexpr (ALIGN_EPI) { if (wr == 1) PG8_BAR; }
    }
    PG8_WAIT_V(0);
    if constexpr (!ALIGN_EPI) { if (wr == 0) PG8_BAR; }
    PG8_BAR;
    if constexpr (Epi::AFTER_DRAIN) { E.fused(acc, cur, wr, wc, fr, fq, lds, wid, lane); S.done(cur); }
#undef PG8_SA
#undef PG8_SB
#undef PG8_STAGE
#undef PG8_LDA
#undef PG8_LDB
#undef PG8_MMA
#undef PG8_WAIT_V
#undef PG8_WAIT_L
#undef PG8_BAR
#undef PG8_SCHED
}
}
namespace fox {
typedef unsigned short bf16;
typedef short bf16x8 __attribute__((ext_vector_type(8)));
typedef short s16x4 __attribute__((ext_vector_type(4)));
typedef float f32x16 __attribute__((ext_vector_type(16)));
typedef float f32x4 __attribute__((ext_vector_type(4)));
typedef unsigned u32x4 __attribute__((ext_vector_type(4)));
constexpr int D = 128, NW = 8, QBLK = 32, KVBLK = 64, QB = NW * QBLK;
constexpr int SHM_V = KVBLK * D * 2, SHM_K = KVBLK * D * 2;
constexpr int LDS_WS = 2 * SHM_V + 2 * SHM_K, LDS_KX = LDS_WS + NW * 64 * 4, LDS_Q = LDS_KX + 2 * 1024, LDS_BYTES = LDS_Q + NW * QBLK * D * 2;
constexpr float SCALE = 0.08838834764831845f;
constexpr float C2 = 1.4426950408889634f * SCALE;
constexpr float THR = 8.f;

#define KSWZ(row, colB) ((row) * 256 + ((colB) ^ (((row) & 7) << 4)))
#define SBAR() __builtin_amdgcn_sched_barrier(0)
__device__ __forceinline__ int v_st(int k, int c) { const int kk = (k & ~0xC) | ((k & 4) << 1) | ((k & 8) >> 1); return ((kk >> 3) * 4 + (c >> 5)) * 512 + ((kk & 7) * 32 + (c & 31)) * 2; }
__device__ __forceinline__ int v_rd_base(int lane) { return ((lane & 3) << 3) | (((lane >> 2) & 3) << 6) | (((lane >> 4) & 1) << 5) | (((lane >> 5) & 1) << 8); }
constexpr int v_rd_off(int d0, int ks, int half) { return d0 * 512 + ks * 4096 + half * 2048; }
__device__ __forceinline__ int crow(int r, int hi) { return (r & 3) + 8 * (r >> 2) + 4 * hi; }
__device__ __forceinline__ unsigned cvtpk(float lo, float hi) { unsigned r; asm volatile("v_cvt_pk_bf16_f32 %0, %1, %2" : "=v"(r) : "v"(lo), "v"(hi)); return r; }
__device__ __forceinline__ bf16x8 load8(const bf16* p) { return *reinterpret_cast<const bf16x8*>(p); }
__device__ __forceinline__ void mask_tile(f32x16& p0, f32x16& p1, int dq) {
    const float NEG = -__builtin_inff();
#pragma unroll
    for (int r = 0; r < 16; ++r) {
        const int c = (r & 3) + 8 * (r >> 2);
        if (dq - c < 0) p0[r] = NEG;
        if (dq - c - 32 < 0) p1[r] = NEG;
    }
}
__device__ __forceinline__ void partialSM(f32x16& p0, f32x16& p1, float& m_reg, float& mn, float& alpha) {
    float pmax = p0[0];
#pragma unroll
    for (int r = 1; r < 16; ++r) pmax = fmaxf(pmax, p0[r]);
#pragma unroll
    for (int r = 0; r < 16; ++r) pmax = fmaxf(pmax, p1[r]);
    { auto rr = __builtin_amdgcn_permlane32_swap(__float_as_uint(pmax), __float_as_uint(pmax), false, false);
      pmax = fmaxf(__uint_as_float(rr[0]), __uint_as_float(rr[1])); }
    if (__builtin_expect(__all((pmax - m_reg) * SCALE <= THR), 1)) { mn = m_reg; alpha = 1.f; }
    else { mn = fmaxf(m_reg, pmax); alpha = __builtin_amdgcn_exp2f((m_reg - mn) * C2); m_reg = mn; }
    const float mnL = -mn * C2;
#pragma unroll
    for (int r = 0; r < 16; ++r) p0[r] = fmaf(p0[r], C2, mnL);
#pragma unroll
    for (int r = 0; r < 16; ++r) p1[r] = fmaf(p1[r], C2, mnL);
#pragma unroll
    for (int r = 0; r < 16; ++r) p0[r] = __builtin_amdgcn_exp2f(p0[r]);
}
__device__ __forceinline__ void finishSM(f32x16& p0, f32x16& p1, float alpha, float& l_reg, bf16x8& pa0, bf16x8& pa1, bf16x8& pa2, bf16x8& pa3) {
#pragma unroll
    for (int r = 0; r < 16; ++r) p1[r] = __builtin_amdgcn_exp2f(p1[r]);
    float ps = 0;
#pragma unroll
    for (int r = 0; r < 16; ++r) ps += p0[r];
#pragma unroll
    for (int r = 0; r < 16; ++r) ps += p1[r];
    { auto rr = __builtin_amdgcn_permlane32_swap(__float_as_uint(ps), __float_as_uint(ps), false, false);
      ps = __uint_as_float(rr[0]) + __uint_as_float(rr[1]); }
    l_reg = l_reg * alpha + ps;
#define PK4(P, B_, OUT) do { unsigned a0 = cvtpk(P[B_+0], P[B_+1]), a1 = cvtpk(P[B_+2], P[B_+3]);                          \
        unsigned b0 = cvtpk(P[B_+4], P[B_+5]), b1 = cvtpk(P[B_+6], P[B_+7]);                                             \
        auto r0 = __builtin_amdgcn_permlane32_swap(a0, b0, false, false); auto r1 = __builtin_amdgcn_permlane32_swap(a1, b1, false, false); \
        u32x4 w = {r0[0], r1[0], r0[1], r1[1]}; OUT = *reinterpret_cast<bf16x8*>(&w); } while (0)
    PK4(p0, 0, pa0); PK4(p0, 8, pa1); PK4(p1, 0, pa2); PK4(p1, 8, pa3);
#undef PK4
}
template <int KB>
__device__ __forceinline__ void qkt(f32x16& p0, f32x16& p1, const char* K_lds, const char* KX_lds, int r32, int hi, const char* Qw) {
    p0 = f32x16{}; p1 = f32x16{};
    {
        const short one = hi ? (short)0 : (short)0x3F80;
        const bf16x8 qx = {one, one, one, 0, 0, 0, 0, 0};
        const bf16x8 x0 = *reinterpret_cast<const bf16x8*>(KX_lds + KB * 1024 + r32 * 16);
        const bf16x8 x1 = *reinterpret_cast<const bf16x8*>(KX_lds + KB * 1024 + (32 + r32) * 16);
        p0 = __builtin_amdgcn_mfma_f32_32x32x16_bf16(x0, qx, p0, 0, 0, 0);
        p1 = __builtin_amdgcn_mfma_f32_32x32x16_bf16(x1, qx, p1, 0, 0, 0); }
    const char* kb[4]; const char* qb[4];
#pragma unroll
    for (int dd = 0; dd < 4; ++dd) { const int sw = KSWZ(r32, (dd * 16 + hi * 8) * 2); kb[dd] = K_lds + KB * SHM_K + sw; qb[dd] = Qw + sw; }
#pragma unroll
    for (int d0 = 0; d0 < 8; ++d0) { const char* a = kb[d0 & 3] + (d0 >> 2) * 128;
        bf16x8 b0 = *reinterpret_cast<const bf16x8*>(a);
        bf16x8 b1 = *reinterpret_cast<const bf16x8*>(a + 32 * 256);
        bf16x8 q = *reinterpret_cast<const bf16x8*>(qb[d0 & 3] + (d0 >> 2) * 128);
        p0 = __builtin_amdgcn_mfma_f32_32x32x16_bf16(b0, q, p0, 0, 0, 0);
        p1 = __builtin_amdgcn_mfma_f32_32x32x16_bf16(b1, q, p1, 0, 0, 0); }
}
template <int VB>
__device__ __forceinline__ void pv_tile(f32x16* o, int vb0, bf16x8 pa0, bf16x8 pa1, bf16x8 pa2, bf16x8 pa3) {
#define TRRD(dst, off) asm volatile("ds_read_b64_tr_b16 %0, %1 offset:%2" : "=&v"(dst) : "v"(vb0), "i"(off) : "memory")
#define PV_D0(d0) do { s16x4 l0, l1, l2, l3, h0, h1, h2, h3; constexpr int b_ = VB * SHM_V + v_rd_off(d0, 0, 0); \
        TRRD(l0, b_); TRRD(h0, b_ + 2048); TRRD(l1, b_ + 4096); TRRD(h1, b_ + 6144); TRRD(l2, b_ + 8192); TRRD(h2, b_ + 10240); TRRD(l3, b_ + 12288); TRRD(h3, b_ + 14336); \
        asm volatile("s_waitcnt lgkmcnt(0)" ::: "memory"); SBAR();   \
        o[d0] = __builtin_amdgcn_mfma_f32_32x32x16_bf16(pa0, (bf16x8){l0[0], l0[1], l0[2], l0[3], h0[0], h0[1], h0[2], h0[3]}, o[d0], 0, 0, 0);   \
        o[d0] = __builtin_amdgcn_mfma_f32_32x32x16_bf16(pa1, (bf16x8){l1[0], l1[1], l1[2], l1[3], h1[0], h1[1], h1[2], h1[3]}, o[d0], 0, 0, 0);   \
        o[d0] = __builtin_amdgcn_mfma_f32_32x32x16_bf16(pa2, (bf16x8){l2[0], l2[1], l2[2], l2[3], h2[0], h2[1], h2[2], h2[3]}, o[d0], 0, 0, 0);   \
        o[d0] = __builtin_amdgcn_mfma_f32_32x32x16_bf16(pa3, (bf16x8){l3[0], l3[1], l3[2], l3[3], h3[0], h3[1], h3[2], h3[3]}, o[d0], 0, 0, 0); } while (0)
    PV_D0(0); PV_D0(1); PV_D0(2); PV_D0(3);
#undef PV_D0
#undef TRRD
}

struct BlockRef { unsigned q, k, v, kx, o; int P0; };
struct Bases { const bf16* P; const bf16* KX; bf16* O; };
struct Seam { bf16x8 st_v0, st_v1, st_k0, st_k1; };
#define ROW(p, k0, rr) ((p) + (size_t)(k0) * PQ + (unsigned)((rr) * PQ + sc))
#define VMW() asm volatile("s_waitcnt vmcnt(0)" ::: "memory")
#define VMWN(n) asm volatile("s_waitcnt vmcnt(%0)" :: "i"(n) : "memory")
#define SLOAD_H(Kp, Vp, KXp, k0, kxb) do { S.st_v0 = load8(ROW(Vp, k0, sr)); S.st_v1 = load8(ROW(Vp, k0, 32 + sr));              \
                         S.st_k0 = load8(ROW(Kp, k0, sr)); S.st_k1 = load8(ROW(Kp, k0, 32 + sr));                                 \
                         if (wid == 0) __builtin_amdgcn_global_load_lds((const unsigned*)((KXp) + (size_t)(k0) * 8 + (unsigned)(lane * 8)), (__attribute__((address_space(3))) unsigned*)(KX_lds + (kxb) * 1024), 16, 0, 0); } while (0)
#define SWRITE_HK(bf) do { *(bf16x8*)(K_lds + (bf) * SHM_K + kws) = S.st_k0; *(bf16x8*)(K_lds + (bf) * SHM_K + kws + 32 * 256) = S.st_k1; } while (0)
#define SWRITE_HV(bf) do { *(bf16x8*)(V_lds + (bf) * SHM_V + vst0) = S.st_v0; *(bf16x8*)(V_lds + (bf) * SHM_V + vst1) = S.st_v1; } while (0)
#define SWRITE_H(bf) do { SWRITE_HV(bf); SWRITE_HK(bf); } while (0)
#define QLOAD(qoff) do { _Pragma("unroll") for (int i_ = 0; i_ < 8; ++i_) { const int row_ = 4 * i_ + (lane >> 4);                                             \
        __builtin_amdgcn_global_load_lds((const unsigned*)(Bs.P + (qoff) + (size_t)(wid * QBLK + 4 * i_) * PQ + (unsigned)((lane >> 4) * PQ + (((lane & 15) ^ (row_ & 7)) * 8))), \
                                         (__attribute__((address_space(3))) unsigned*)(Qw + i_ * 1024), 16, 0, 0); } } while (0)
template <int PQ, int PO>
__device__ __forceinline__ void fox_prime(const Bases& Bs, const BlockRef& cur, char* lds, Seam& S) {
    const int tid = threadIdx.x, wid = __builtin_amdgcn_readfirstlane(tid >> 6), lane = tid & 63, r32 = lane & 31, hi = lane >> 5;
    const int sr = tid >> 4, sc = (tid & 15) * 8, kws = KSWZ(sr, sc * 2); char* K_lds = lds + 2 * SHM_V; char* KX_lds = lds + LDS_KX; char* Qw = lds + LDS_Q + wid * (QBLK * D * 2);
    QLOAD(cur.q);
    SLOAD_H(Bs.P + cur.k, Bs.P + cur.v, Bs.KX + (size_t)cur.kx * 8, 0, 0); VMW(); SWRITE_HK(0);
    __syncthreads();
}
template <int PQ, int PO>
__device__ __forceinline__ void fox_block(const Bases& Bs, const BlockRef& cur, const BlockRef& nxt, char* lds, Seam& S) {
    const int tid = threadIdx.x, wid = __builtin_amdgcn_readfirstlane(tid >> 6), lane = tid & 63, r32 = lane & 31, hi = lane >> 5;
    const int NT = (cur.P0 + QB - 1) / KVBLK + 1;
    const int qlo = cur.P0 + wid * QBLK, qm = qlo + r32 - 4 * hi;
    char* V_lds = lds; char* K_lds = lds + 2 * SHM_V;
    float* ws = (float*)(lds + LDS_WS) + wid * 64; float* li_l = ws, * al_l = ws + 32; char* KX_lds = lds + LDS_KX; char* Qw = lds + LDS_Q + wid * (QBLK * D * 2);
    float m_reg = -1e30f, l_reg = 0; f32x16 o[4] = {};
    const int sr = tid >> 4, sc = (tid & 15) * 8, vst0 = v_st(sr, sc), vst1 = v_st(32 + sr, sc), kws = KSWZ(sr, sc * 2);
    const int vb0 = (int)(uintptr_t)V_lds + v_rd_base(lane);
    const bf16* Kh = Bs.P + cur.k; const bf16* Vh = Bs.P + cur.v; const bf16* KXh = Bs.KX + (size_t)cur.kx * 8;
#define RESC(a) do { if (__any((a) < 1.f)) { if (hi == 0) al_l[r32] = (a); asm volatile("s_waitcnt lgkmcnt(0)" ::: "memory");              \
                     for (int d_ = 0; d_ < 4; ++d_) for (int r = 0; r < 16; ++r) o[d_][r] *= al_l[crow(r, hi)]; } } while (0)
#define KBASE(t) ((t) * KVBLK)
#define MASKT(P0_, P1_, t) do { const int kb_ = KBASE(t); if (kb_ + KVBLK - 1 > qlo) mask_tile(P0_, P1_, qm - kb_); } while (0)
    constexpr int NQL = 8;
#define SEAM_K0() do { VMWN(NQL); SWRITE_HK(0); SBAR(); } while (0)
    f32x16 pA0, pA1, pB0, pB1; float mnA, mnB, alA, alB; bf16x8 pa0, pa1, pa2, pa3;
    SWRITE_HV(0); SBAR();
    if (NT > 1) SLOAD_H(Kh, Vh, KXh, KBASE(1), 1);
    SBAR(); qkt<0>(pA0, pA1, K_lds, KX_lds, r32, hi, Qw);
    MASKT(pA0, pA1, 0); partialSM(pA0, pA1, m_reg, mnA, alA);
    if (NT > 1) { VMW(); SWRITE_H(1); }
    __syncthreads();
#define HALF_STEP(PX0, PX1, mnX, alX, PY0, PY1, alY, t, KB, VB, SB) do {                                                      \
        SBAR(); qkt<KB>(PX0, PX1, K_lds, KX_lds, r32, hi, Qw);                                                                    \
        finishSM(PY0, PY1, alY, l_reg, pa0, pa1, pa2, pa3); SBAR();                                                           \
        if ((t) + 1 < NT) { SLOAD_H(Kh, Vh, KXh, KBASE((t) + 1), SB); SBAR(); }                                                 \
        pv_tile<VB>(o, vb0, pa0, pa1, pa2, pa3); MASKT(PX0, PX1, (t)); partialSM(PX0, PX1, m_reg, mnX, alX); \
        __syncthreads();                                                                                                      \
        if ((t) + 1 < NT) { VMW(); SWRITE_H(SB); }                                                                            \
        RESC(alX); __syncthreads(); } while (0)
    for (int t = 1; t + 1 < NT; t += 2) {
        HALF_STEP(pB0, pB1, mnB, alB, pA0, pA1, alA, t, 1, 0, 0);
        HALF_STEP(pA0, pA1, mnA, alA, pB0, pB1, alB, t + 1, 0, 1, 1);
    }
    const bool even = (NT & 1) == 0;
    if (even) { SBAR(); qkt<1>(pB0, pB1, K_lds, KX_lds, r32, hi, Qw); SBAR(); }
    SLOAD_H(Bs.P + nxt.k, Bs.P + nxt.v, Bs.KX + (size_t)nxt.kx * 8, 0, 0); SBAR();
    QLOAD(nxt.q);
    SBAR();
    finishSM(pA0, pA1, alA, l_reg, pa0, pa1, pa2, pa3); SBAR();
    pv_tile<0>(o, vb0, pa0, pa1, pa2, pa3);
    if (even) { MASKT(pB0, pB1, NT - 1); partialSM(pB0, pB1, m_reg, mnB, alB); __syncthreads(); RESC(alB);
        finishSM(pB0, pB1, alB, l_reg, pa0, pa1, pa2, pa3); SBAR(); pv_tile<1>(o, vb0, pa0, pa1, pa2, pa3); }
    SBAR(); SEAM_K0();
    if (hi == 0) li_l[r32] = l_reg; asm volatile("s_waitcnt lgkmcnt(0)" ::: "memory");
    float rli[16];
#pragma unroll
    for (int r = 0; r < 16; ++r) rli[r] = __builtin_amdgcn_rcpf(li_l[crow(r, hi)]);
    bf16* Ow = Bs.O + cur.o + (size_t)(wid * QBLK) * PO;
#pragma unroll
    for (int r = 0; r < 16; ++r) { const int orow = crow(r, hi);
#pragma unroll
        for (int d0 = 0; d0 < 4; ++d0) { const float v = o[d0][r] * rli[r];
            const float vn = __shfl_xor(v, 1);
            if ((r32 & 1) == 0) *(unsigned*)(Ow + (unsigned)(orow * PO + d0 * 32 + r32)) = cvtpk(v, vn); } }
    __syncthreads();
#undef RESC
#undef KBASE
#undef MASKT
#undef SEAM_K0
#undef HALF_STEP
}
#undef ROW
#undef VMW
#undef VMWN
#undef SLOAD_H
#undef SWRITE_HK
#undef SWRITE_HV
#undef SWRITE_H
#undef SBAR
#undef KSWZ
}
#ifndef PG8_SP2
#define PG8_SP2 true
#endif
#ifndef PG8_ALIGN
#define PG8_ALIGN true
#endif
constexpr int NWAVES = 8;
#ifndef MK_ONE_LAUNCH
#define MK_ONE_LAUNCH 1
#endif
constexpr int N_PHASES = 12;

constexpr int BATCH = 2, SEQ = 4096, DM = 4096, M = BATCH * SEQ;
constexpr int HD = 128, NH = 16;
constexpr int FOXW = 2048, GDNW = 2048, FF = 11008, NMOD = 6 * DM;
constexpr int IN_COLS = 14384;
constexpr int NP = 14336;
constexpr int NPP = 14400;
constexpr int NPT = 14400;
constexpr float EPS = 1e-6f;
constexpr int PC_Q = 0, PC_K = 2048, PC_V = 4096, PC_G = 6144, PC_Z = 12288, PC_F = 14336, PC_A = 14352, PC_B = 14368;
constexpr int SRC_F = 6144, SRC_G = 6160, SRC_A = 12304, SRC_B = 12320, SRC_Z = 12336;
constexpr int ADA_KS = 64, ADA_NT = ADA_KS * (NMOD / 256);

constexpr size_t MiB = 1u << 20;
constexpr size_t WS_CTL = 0, CTL_ZERO_BYTES = 65536;
constexpr size_t WS_MOD   = 1 * MiB;
constexpr size_t WS_KX    = 5 * MiB;
constexpr size_t WS_FLS   = 2 * MiB;
constexpr size_t WS_GG    = 3 * MiB;
constexpr size_t WS_GB    = 4 * MiB;
constexpr size_t WS_MODP  = 8 * MiB;
constexpr int LDK = 4224;
constexpr int LDMIX = DM, LDWOUT = DM;
constexpr int LDH = DM, LDWIN = DM;
constexpr int LDH2 = LDK, LDWGU = LDK;
constexpr size_t WS_WIN   = 32 * MiB;
constexpr size_t WS_WOUT  = 152 * MiB;
constexpr size_t WS_WGU   = 188 * MiB;
constexpr size_t WS_WD    = 368 * MiB;
constexpr size_t WS_H     = 456 * MiB;
constexpr size_t WS_MIX   = 524 * MiB;
constexpr size_t WS_P     = 592 * MiB;
constexpr size_t WS_HID   = 592 * MiB;
constexpr size_t WS_GO    = 820 * MiB;
constexpr size_t WS_SP    = WS_GO;
constexpr size_t WS_CH    = 884 * MiB;
constexpr size_t WS_X1    = WS_CH;
constexpr size_t WS_UC    = 1004 * MiB;
constexpr size_t WS_GT    = 7 * MiB;
constexpr size_t WS_END   = 1068 * MiB;
static_assert(WS_WIN + (size_t)NPT * LDWIN * 2 <= WS_WOUT && WS_WOUT + (size_t)DM * LDWOUT * 2 <= WS_WGU && WS_WGU + (size_t)2 * FF * LDWGU * 2 <= WS_WD && WS_WD + (size_t)DM * FF * 2 <= WS_H &&
              WS_H + (size_t)M * LDH2 * 2 <= WS_MIX && LDH2 >= LDH && WS_MIX + (size_t)M * LDMIX * 2 <= WS_P && WS_P + (size_t)M * NPP * 2 <= WS_GO, "d_ws map");
constexpr int CH_W = 0, CH_Q = 16896, CH_KT = 33792, CH_AQ = 51200, CH_BYTES = 61440;
constexpr int RS_W = 264, RS_K = 136;
constexpr int NCHUNK = BATCH * NH * (SEQ / 64);
constexpr int CW_BAR = 4096, CW_QUEUE = 8192;

constexpr int RING_OFF = 0, RING_BYTES = 131072;
constexpr int PHASE_LDS = 143360;
constexpr int LDSCTL_OFF = PHASE_LDS, MISC_OFF = LDSCTL_OFF + 320;
constexpr int LDS_BYTES = 147456;
static_assert(MISC_OFF + 128 <= LDS_BYTES && fox::LDS_BYTES <= PHASE_LDS, "LDS map");

#define GAS __attribute__((address_space(1)))
#define LAS __attribute__((address_space(3)))
typedef unsigned short bf16;
typedef unsigned v4u __attribute__((ext_vector_type(4)));
typedef unsigned v2u __attribute__((ext_vector_type(2)));
typedef float f32x4 __attribute__((ext_vector_type(4)));
typedef GAS unsigned gu32;
#define RLX_AGENT __ATOMIC_RELAXED, __HIP_MEMORY_SCOPE_AGENT
#define LDS_WAIT() asm volatile("s_waitcnt lgkmcnt(0)" ::: "memory")
#define VM_WAIT() asm volatile("s_waitcnt vmcnt(0)" ::: "memory")
__device__ __forceinline__ unsigned f2bf(float f) { unsigned u = __builtin_bit_cast(unsigned, f); return (u + 0x7fffu + ((u >> 16) & 1u)) >> 16; }
typedef float pkf32x2 __attribute__((ext_vector_type(2))); typedef __bf16 pkbf16x2 __attribute__((ext_vector_type(2)));
__device__ __forceinline__ unsigned pk2(float lo, float hi) { pkf32x2 v = {lo, hi}; pkbf16x2 b = __builtin_convertvector(v, pkbf16x2); return __builtin_bit_cast(unsigned, b); }
__device__ __forceinline__ float bf2f(unsigned short h) { return __builtin_bit_cast(float, (unsigned)h << 16); }
__device__ __forceinline__ float bflo(unsigned w) { return __builtin_bit_cast(float, w << 16); }
__device__ __forceinline__ float bfhi(unsigned w) { return __builtin_bit_cast(float, w & 0xffff0000u); }
__device__ __forceinline__ float sigmoidf_(float x) { return 1.0f / (1.0f + __expf(-x)); }
__device__ __forceinline__ float siluf_(float x) { return x * __builtin_amdgcn_rcpf(1.0f + __builtin_amdgcn_exp2f(-1.4426950408889634f * x)); }

#define XB_TMO      128
#define XB_XCNT(j)  (256  + 64 * (j))
#define XB_XSUB(j)  (1280 + 64 * (j))
#define XB_XGEN(j)  (2304 + 64 * (j))
#define XB_TOP      3328
#define XB_TOPGEN   3392
#define XCD_BAR_WORDS 3456
#define XB_SPIN_CAP (1u << 18)

__device__ __forceinline__ unsigned xb_ld(unsigned* p)              { return __hip_atomic_load(p, __ATOMIC_RELAXED, __HIP_MEMORY_SCOPE_AGENT); }
__device__ __forceinline__ unsigned xb_add(unsigned* p, unsigned v) { return __hip_atomic_fetch_add(p, v, __ATOMIC_RELAXED, __HIP_MEMORY_SCOPE_AGENT); }
__device__ __forceinline__ unsigned xb_xcc_id() { return (unsigned)__builtin_amdgcn_s_getreg((3 << 11) | 20) & 0xFu; }
#define XB_SPIN(cond, bar) do { unsigned _sp = 0; while (cond) { __builtin_amdgcn_s_sleep(1); \
    if ((++_sp & 255u) == 0u) { if (xb_ld(&(bar)[XB_TMO])) break; if (_sp > XB_SPIN_CAP) { atomicAdd(&(bar)[XB_TMO], 1u); break; } } } } while (0)

struct XcdBarrier {
    unsigned* bar; unsigned x;
    volatile LAS unsigned* st;
};

__device__ __forceinline__ XcdBarrier xcd_barrier_post(unsigned* bar, volatile LAS unsigned* st) {
    XcdBarrier b; b.bar = bar; b.x = xb_xcc_id(); b.st = st;
    if (threadIdx.x == 0) (void)xb_add(&bar[XB_XCNT(b.x)], 1u);
    return b;
}
__device__ __forceinline__ void xcd_barrier_complete(unsigned* bar, unsigned x, unsigned& nloc, unsigned& nx) {
    const unsigned G = gridDim.x * gridDim.y * gridDim.z;
    unsigned sum, cnt, mine, sp = 0u;
    for (;;) {
        sum = 0u; cnt = 0u; mine = 0u;
#pragma unroll
        for (unsigned j = 0; j < 16; ++j) { const unsigned c = xb_ld(&bar[XB_XCNT(j)]); sum += c; cnt += (c > 0u) ? 1u : 0u; mine = (j == x) ? c : mine; }
        if (sum == G) break;
        __builtin_amdgcn_s_sleep(1);
        if ((++sp & 255u) == 0u) { if (xb_ld(&bar[XB_TMO])) break; if (sp > XB_SPIN_CAP) { atomicAdd(&bar[XB_TMO], 1u); break; } }
    }
    nloc = mine > 0u ? mine : 1u; nx = cnt > 0u ? cnt : 1u;
}

__device__ __forceinline__ void xcd_barrier(const XcdBarrier& b) {
    asm volatile("s_waitcnt vmcnt(0)" ::: "memory");
    __syncthreads();
    if (threadIdx.x == 0) {
        unsigned* bar = b.bar;
        __builtin_amdgcn_s_waitcnt(0);
        unsigned nloc = b.st[0], nx = b.st[1];
        if (nloc == 0u) { xcd_barrier_complete(bar, b.x, nloc, nx); b.st[0] = nloc; b.st[1] = nx; }
        const unsigned old = xb_add(&bar[XB_XSUB(b.x)], 1u);
        const unsigned gen = old / nloc;
        if (old + 1u == (gen + 1u) * nloc) {
            __builtin_amdgcn_fence(__ATOMIC_RELEASE, "agent");
            asm volatile("s_waitcnt vmcnt(0)" ::: "memory");
            const unsigned og = xb_add(&bar[XB_TOP], 1u);
            const unsigned tg = og / nx;
            if (og + 1u == (tg + 1u) * nx) xb_add(&bar[XB_TOPGEN], 1u);
            else XB_SPIN(xb_ld(&bar[XB_TOPGEN]) == tg, bar);
            __builtin_amdgcn_fence(__ATOMIC_ACQUIRE, "agent");
            xb_add(&bar[XB_XGEN(b.x)], 1u);
            asm volatile("s_waitcnt vmcnt(0)" ::: "memory");
        } else {
            XB_SPIN(xb_ld(&bar[XB_XGEN(b.x)]) == gen, bar);
            __builtin_amdgcn_fence(__ATOMIC_ACQUIRE, "agent");
            asm volatile("s_waitcnt vmcnt(0)" ::: "memory");
        }
    }
    __syncthreads();
}

struct Frame {
    LAS unsigned char* lds;
    volatile LAS unsigned* MISC;
    gu32* ctl;
    int tid, lane, wave;
    int vcu, G;
    unsigned char* ws;
    const float *x, *c, *w_ada, *b_ada, *norm1_g, *w_in, *fox_q_norm, *fox_k_norm, *fox_f_bias, *gdn_conv_w, *gdn_a_log, *gdn_dt_bias, *gdn_norm_w, *w_out, *norm2_g, *w_gate, *w_up, *w_down;
    float* out;
};
__device__ __forceinline__ float wave_sum(float v) {
#pragma unroll
    for (int o = 1; o < 64; o <<= 1) v += __shfl_xor(v, o);
    return v;
}
__device__ __forceinline__ float sum16(float v) {
#pragma unroll
    for (int o = 1; o < 16; o <<= 1) v += __shfl_xor(v, o);
    return v;
}

template <bool NT> __device__ __forceinline__ void ada_task(Frame& F, int ks, int nc, int lane) {
    float* modp = (float*)(F.ws + WS_MODP);
    const int n = nc * 256 + lane * 4, k0 = ks * (DM / ADA_KS);
    const float* wp = F.w_ada + (size_t)k0 * NMOD + n;
    LAS unsigned char* scr = F.lds + RING_OFF + F.wave * 16640;
    f32x4 a0 = {0.f, 0.f, 0.f, 0.f}, a1 = {0.f, 0.f, 0.f, 0.f};
#define ADA_ISSUE(src, buf) do { _Pragma("unroll") for (int r_ = 0; r_ < 8; ++r_) \
        __builtin_amdgcn_global_load_lds((const unsigned*)((src) + (size_t)r_ * NMOD), (LAS unsigned*)((buf) + r_ * 1024), 16, 0, NT ? 2 : 0); } while (0)
#define ADA_EAT(buf, kb) do { _Pragma("unroll") for (int r = 0; r < 8; ++r) { const f32x4 w = *(const LAS f32x4*)((buf) + r * 1024 + lane * 16); \
        const float c0 = __builtin_bit_cast(float, __builtin_amdgcn_readlane(__builtin_bit_cast(int, c0v), (kb) + r)), c1 = __builtin_bit_cast(float, __builtin_amdgcn_readlane(__builtin_bit_cast(int, c1v), (kb) + r)); \
        a0 += w * c0; a1 += w * c1; } \
        asm volatile("s_waitcnt lgkmcnt(0)" ::: "memory"); } while (0)
    const float c0v = siluf_(F.c[k0 + lane]), c1v = siluf_(F.c[DM + k0 + lane]);
    ADA_ISSUE(wp, scr);
#pragma unroll 1
    for (int bt = 0; bt < 7; ++bt) {
        LAS unsigned char* cur = scr + (bt & 1) * 8192; LAS unsigned char* nxt = scr + ((bt + 1) & 1) * 8192;
        ADA_ISSUE(wp + (size_t)(bt + 1) * 8 * NMOD, nxt); asm volatile("s_waitcnt vmcnt(8)" ::: "memory");
        ADA_EAT(cur, bt * 8);
    }
    asm volatile("s_waitcnt vmcnt(0)" ::: "memory");
    ADA_EAT(scr + 8192, 56);
#undef ADA_EAT
#undef ADA_ISSUE
    *(f32x4*)(modp + (size_t)(ks * 2 + 0) * NMOD + n) = a0;
    *(f32x4*)(modp + (size_t)(ks * 2 + 1) * NMOD + n) = a1;
}
template <bool NT> __device__ __forceinline__ void p0_ada(Frame& F, int nc_lo, int nc_hi, int widx, int nworkers) {
    const int gw = widx * NWAVES + F.wave, NGW = nworkers * NWAVES;
    const int ncn = nc_hi - nc_lo;
    for (int task = gw; task < ADA_KS * ncn; task += NGW) ada_task<NT>(F, task / ncn, nc_lo + task % ncn, F.lane);
}
struct TrItem { const float* colp; bf16* dst; int ldw, K; };
template <bool NT> __device__ __forceinline__ void tr_load(f32x4 (&v)[16], const TrItem& it, int lane) {
    const int kq = lane >> 4;
#pragma unroll
    for (int i = 0; i < 16; ++i) { const f32x4* p = (const f32x4*)(it.colp + (size_t)(4 * i + kq) * it.ldw);
        v[i] = it.colp ? (NT ? __builtin_nontemporal_load(p) : *p) : (f32x4){0.f, 0.f, 0.f, 0.f}; }
}
template <bool NT> __device__ __forceinline__ void tr_store(const f32x4 (&v)[16], const TrItem& it, LAS float* scr, int lane) {
    const int kq = lane >> 4, g = lane & 15;
#pragma unroll
    for (int i = 0; i < 16; ++i) { LAS float* d = scr + (4 * i + kq) * 65 + 4 * g; d[0] = v[i].x; d[1] = v[i].y; d[2] = v[i].z; d[3] = v[i].w; }
    LDS_WAIT(); asm volatile("" ::: "memory");
    const int c = lane >> 3, rr = lane & 7;
#pragma unroll
    for (int j = 0; j < 8; ++j) { const int n = 8 * j + rr; const LAS float* s = scr + (8 * c) * 65 + n;
        v4u o; o.x = pk2(s[0 * 65], s[1 * 65]); o.y = pk2(s[2 * 65], s[3 * 65]); o.z = pk2(s[4 * 65], s[5 * 65]); o.w = pk2(s[6 * 65], s[7 * 65]);
        GAS v4u* q = (GAS v4u*)(it.dst + (size_t)n * it.K + 8 * c); if (NT) __builtin_nontemporal_store(o, q); else *q = o; }
    LDS_WAIT(); asm volatile("" ::: "memory");
}
__device__ __forceinline__ int win_srccol(int n) {
    if (n < PC_G) return n;
    if (n < PC_Z) return SRC_G + (n - PC_G);
    if (n < NP) return SRC_Z + (n - PC_Z);
    if (n < NP + 16) return SRC_F + (n - NP);
    if (n < NP + 32) return SRC_A + (n - NP - 16);
    if (n < NP + 48) return SRC_B + (n - NP - 32);
    return -1;
}
__device__ __forceinline__ TrItem p0_item(Frame& F, int it, int g4) {
    constexpr int I_IN = (DM / 64) * (NPT / 64), I_OUT = (DM / 64) * (DM / 64), I_GU = (DM / 64) * (2 * FF / 64);
    bf16* win_t = (bf16*)(F.ws + WS_WIN); bf16* wout_t = (bf16*)(F.ws + WS_WOUT); bf16* wgu_t = (bf16*)(F.ws + WS_WGU); bf16* wd_t = (bf16*)(F.ws + WS_WD);
    TrItem t; int r = it;
    if (r < I_IN) { const int kb = r % (DM / 64), nb = r / (DM / 64); const int sc = win_srccol(nb * 64 + g4);
        t.colp = sc >= 0 ? F.w_in + (size_t)(kb * 64) * IN_COLS + sc : nullptr; t.ldw = IN_COLS; t.K = LDWIN; t.dst = win_t + (size_t)(nb * 64) * LDWIN + kb * 64; return t; } r -= I_IN;
    if (r < I_OUT) { const int kb = r % (DM / 64), nb = r / (DM / 64);
        t.colp = F.w_out + (size_t)(kb * 64) * DM + nb * 64 + g4; t.ldw = DM; t.K = LDWOUT; t.dst = wout_t + (size_t)(nb * 64) * LDWOUT + kb * 64; return t; } r -= I_OUT;
    if (r < I_GU) { const int kb = r % (DM / 64), nb = r / (DM / 64); const int n = nb * 64 + g4;
        const float* src = ((n >> 7) & 1) ? F.w_up : F.w_gate;
        t.colp = src + (size_t)(kb * 64) * FF + (n >> 8) * 128 + (n & 127); t.ldw = FF; t.K = LDWGU; t.dst = wgu_t + (size_t)(nb * 64) * LDWGU + kb * 64; return t; } r -= I_GU;
    { const int kb = r % (FF / 64), nb = r / (FF / 64);
        t.colp = F.w_down + (size_t)(kb * 64) * DM + nb * 64 + g4; t.ldw = DM; t.K = FF; t.dst = wd_t + (size_t)(nb * 64) * FF + kb * 64; return t; }
}
constexpr int P0_ITEMS_ALL = (DM / 64) * (NPT / 64) + (DM / 64) * (DM / 64) + (DM / 64) * (2 * FF / 64) + (FF / 64) * (DM / 64);
constexpr int P0_ITEMS_IN = (DM / 64) * (NPT / 64);
constexpr int P6_ADA_WGS = 32;
constexpr int P6_CONV_WGS = 64;
constexpr int P0_ITEMS_DOWN = (FF / 64) * (DM / 64) * 7 / 8;
template <bool NT> __device__ __forceinline__ void p0_weights(Frame& F, int lo, int NITEMS, int widx, int nworkers) {
    LAS float* scr = (LAS float*)(F.lds + RING_OFF + F.wave * 16640);
    const int gw = widx * NWAVES + F.wave, NGW = nworkers * NWAVES;
    const int g4 = (F.lane & 15) * 4;
    f32x4 va[16], vb[16];
    int it = lo + gw; if (it >= NITEMS) return;
    TrItem ta = p0_item(F, it, g4), tb = ta;
    tr_load<NT>(va, ta, F.lane);
    for (;;) {
        const bool hb = it + NGW < NITEMS;
        if (hb) { tb = p0_item(F, it + NGW, g4); tr_load<NT>(vb, tb, F.lane); }
        tr_store<NT>(va, ta, scr, F.lane);
        if (!hb) break;
        const bool ha = it + 2 * NGW < NITEMS;
        if (ha) { ta = p0_item(F, it + 2 * NGW, g4); tr_load<NT>(va, ta, F.lane); }
        tr_store<NT>(vb, tb, scr, F.lane);
        if (!ha) break;
        it += 2 * NGW;
    }
}
__device__ __forceinline__ void p1_modreduce(Frame& F, int n_lo, int n_hi) {
    const float* modp = (const float*)(F.ws + WS_MODP); float* mod = (float*)(F.ws + WS_MOD);
    const int nn = n_hi - n_lo, ntask = 2 * nn / 64;
    LAS float* red = (LAS float*)(F.lds + RING_OFF);
    for (int task = F.vcu; task < ntask; task += F.G) {
        const int b = task / (nn / 64), n = n_lo + (task % (nn / 64)) * 64 + F.lane;
        const float* p = modp + (size_t)(F.wave * 8 * 2 + b) * NMOD + n;
        float v[8];
#pragma unroll
        for (int k = 0; k < 8; ++k) v[k] = p[(size_t)k * 2 * NMOD];
        red[F.wave * 64 + F.lane] = ((v[0] + v[1]) + (v[2] + v[3])) + ((v[4] + v[5]) + (v[6] + v[7]));
        __syncthreads();
        if (F.wave == 0) { float s = F.b_ada[n];
#pragma unroll
            for (int w = 0; w < NWAVES; ++w) s += red[w * 64 + F.lane];
            mod[(size_t)b * NMOD + n] = s; }
        __syncthreads();
    }
}
__device__ __forceinline__ void norm_mod_stage(Frame& F, const float* gain, int shift_chunk, int scale_chunk) {
    const float* mod = (const float*)(F.ws + WS_MOD);
    LAS f32x4* A4 = (LAS f32x4*)(F.lds + RING_OFF); LAS f32x4* S4 = A4 + 2 * (DM / 4);
#pragma unroll 1
    for (int b = 0; b < 2; ++b)
#pragma unroll 1
        for (int c4 = F.tid; c4 < DM / 4; c4 += NWAVES * 64) {
            const f32x4 g = ((const f32x4*)gain)[c4], sc = ((const f32x4*)(mod + (size_t)b * NMOD + scale_chunk * DM))[c4], sh = ((const f32x4*)(mod + (size_t)b * NMOD + shift_chunk * DM))[c4];
            A4[b * (DM / 4) + c4] = g * (1.0f + sc); S4[b * (DM / 4) + c4] = sh; }
    __syncthreads();
}
__device__ __forceinline__ void norm_mod_rows(Frame& F, const float* src, int ldh) {
    const int gw = F.vcu * NWAVES + F.wave, NGW = F.G * NWAVES;
    bf16* H = (bf16*)(F.ws + WS_H);
    const LAS f32x4* A4 = (const LAS f32x4*)(F.lds + RING_OFF); const LAS f32x4* S4 = A4 + 2 * (DM / 4);
#pragma unroll 1
    for (int row = gw; row < M; row += NGW) {
        const int b = row / SEQ;
        const GAS f32x4* xr = (const GAS f32x4*)(src + (size_t)row * DM) + F.lane;
        f32x4 v[16]; float ss = 0.f;
#pragma unroll
        for (int j = 0; j < 16; ++j) { v[j] = xr[64 * j]; ss += (v[j].x * v[j].x + v[j].y * v[j].y) + (v[j].z * v[j].z + v[j].w * v[j].w); }
        const float rstd = 1.0f / sqrtf(wave_sum(ss) * (1.0f / DM) + EPS);
        const LAS f32x4* ap = A4 + b * (DM / 4) + F.lane; const LAS f32x4* sp = S4 + b * (DM / 4) + F.lane;
        GAS v2u* o8 = (GAS v2u*)(H + (size_t)row * ldh) + F.lane;
#pragma unroll
        for (int j = 0; j < 16; ++j) { const f32x4 y = (v[j] * rstd) * ap[64 * j] + sp[64 * j];
            v2u w; w.x = pk2(y.x, y.y); w.y = pk2(y.z, y.w); o8[64 * j] = w;
            if ((j & 3) == 3) asm volatile("" ::: "memory"); }
    }
}
__device__ __forceinline__ void norm_mod_rows_b16(Frame& F, const bf16* src, int ldh) {
    const int gw = F.vcu * NWAVES + F.wave, NGW = F.G * NWAVES;
    bf16* H = (bf16*)(F.ws + WS_H);
    const LAS f32x4* A4 = (const LAS f32x4*)(F.lds + RING_OFF); const LAS f32x4* S4 = A4 + 2 * (DM / 4);
#pragma unroll 1
    for (int row = gw; row < M; row += NGW) {
        const int b = row / SEQ;
        const GAS v4u* xr = (const GAS v4u*)(src + (size_t)row * DM) + F.lane;
        v4u v[8]; float ss = 0.f;
#pragma unroll
        for (int j = 0; j < 8; ++j) { v[j] = xr[64 * j];
            const float e0 = bflo(v[j].x), e1 = bfhi(v[j].x), e2 = bflo(v[j].y), e3 = bfhi(v[j].y), e4 = bflo(v[j].z), e5 = bfhi(v[j].z), e6 = bflo(v[j].w), e7 = bfhi(v[j].w);
            ss += ((e0 * e0 + e1 * e1) + (e2 * e2 + e3 * e3)) + ((e4 * e4 + e5 * e5) + (e6 * e6 + e7 * e7)); }
        const float rstd = 1.0f / sqrtf(wave_sum(ss) * (1.0f / DM) + EPS);
        const LAS f32x4* ap = A4 + b * (DM / 4) + 2 * F.lane; const LAS f32x4* sp = S4 + b * (DM / 4) + 2 * F.lane;
        GAS v4u* o8 = (GAS v4u*)(H + (size_t)row * ldh) + F.lane;
#pragma unroll
        for (int j = 0; j < 8; ++j) {
            const f32x4 x0 = {bflo(v[j].x), bfhi(v[j].x), bflo(v[j].y), bfhi(v[j].y)}, x1 = {bflo(v[j].z), bfhi(v[j].z), bflo(v[j].w), bfhi(v[j].w)};
            const f32x4 y0 = (x0 * rstd) * ap[128 * j] + sp[128 * j], y1 = (x1 * rstd) * ap[128 * j + 1] + sp[128 * j + 1];
            v4u w; w.x = pk2(y0.x, y0.y); w.y = pk2(y0.z, y0.w); w.z = pk2(y1.x, y1.y); w.w = pk2(y1.z, y1.w); o8[64 * j] = w;
            if ((j & 1) == 1) asm volatile("" ::: "memory"); }
    }
}
__device__ __forceinline__ void p4_post(Frame& F) {
    const int gw = F.vcu * NWAVES + F.wave, NGW = F.G * NWAVES;
    bf16* P = (bf16*)(F.ws + WS_P);
    float* GG = (float*)(F.ws + WS_GG); float* GB = (float*)(F.ws + WS_GB); float* FLS = (float*)(F.ws + WS_FLS);
    const int l16 = F.lane & 15, sub = F.lane >> 4;
    for (int row = gw; row < M; row += NGW) {
        const int b = row / SEQ, t = row % SEQ;
        if (F.lane < 48) {
            const float* sp = (const float*)(F.ws + WS_SP) + (size_t)row * 64 + F.lane;
            float v = 0.f;
#pragma unroll
            for (int ks = 0; ks < 8; ++ks) v += sp[(size_t)ks * M * 64];
            const int h = F.lane & 15; const size_t o = (size_t)(b * NH + h) * SEQ + t;
            if (F.lane < 16) { const float z = v + F.fox_f_bias[h]; FLS[o] = (z < 0.f ? z : 0.f) - log1pf(expf(-fabsf(z))); }
            else if (F.lane < 32) { const float xs = v + F.gdn_dt_bias[h]; const float sp_ = xs > 20.f ? xs : log1pf(expf(xs)); GG[o] = -expf(F.gdn_a_log[h]) * sp_; }
            else GB[o] = 1.0f / (1.0f + expf(-v));
        }
    }
}
__device__ __forceinline__ void p5_kx(Frame& F) {
    for (int item = F.vcu; item < BATCH * NH * 8; item += F.G) {
        const int bh = item >> 3, sg = item & 7;
        const float* fls = (const float*)(F.ws + WS_FLS) + (size_t)bh * SEQ; bf16* KX = (bf16*)(F.ws + WS_KX);
        float pre = 0.f;
#pragma unroll
        for (int j = 0; j < 14; ++j) { const bool ok = j < 2 * sg;
            const f32x4 v = *(const f32x4*)(fls + (size_t)(ok ? F.lane * 2 * sg + j : 0) * 4); pre += ok ? (v.x + v.y) + (v.z + v.w) : 0.f; }
        pre = wave_sum(pre);
        const float* fp = fls + sg * 512 + F.lane * 8;
        const f32x4 v0 = *(const f32x4*)fp, v1 = *(const f32x4*)(fp + 4);
        float ls[8]; float tot = 0.f;
        tot += v0.x; ls[0] = tot; tot += v0.y; ls[1] = tot; tot += v0.z; ls[2] = tot; tot += v0.w; ls[3] = tot;
        tot += v1.x; ls[4] = tot; tot += v1.y; ls[5] = tot; tot += v1.z; ls[6] = tot; tot += v1.w; ls[7] = tot;
        float incl = tot;
#pragma unroll
        for (int o = 1; o < 64; o <<= 1) { const float u = __shfl_up(incl, o); if (F.lane >= o) incl += u; }
        const float base = pre + incl - tot;
        GAS v4u* kx = (GAS v4u*)(KX + ((size_t)bh * SEQ + sg * 512 + F.lane * 8) * 8);
#pragma unroll
        for (int i = 0; i < 8; ++i) { const float xj = -11.313708498984761f * (base + ls[i]);
            const unsigned hi_ = f2bf(xj); const float r1 = xj - __builtin_bit_cast(float, hi_ << 16);
            const unsigned mid_ = f2bf(r1); const float r2 = r1 - __builtin_bit_cast(float, mid_ << 16);
            const unsigned lo_ = f2bf(r2);
            v4u w; w.x = hi_ | (mid_ << 16); w.y = lo_; w.z = 0u; w.w = 0u; kx[i] = w; }
    }
}
__device__ __forceinline__ fox::BlockRef fox_ref(int bh, int qb) {
    const int b = bh / NH, h = bh % NH;
    fox::BlockRef r;
    r.q = (unsigned)((b * SEQ + qb * 256) * NPP + PC_Q + h * HD);
    r.k = (unsigned)((b * SEQ) * NPP + PC_K + h * HD);
    r.v = (unsigned)((b * SEQ) * NPP + PC_V + h * HD);
    r.kx = (unsigned)(bh * SEQ);
    r.o = (unsigned)((b * SEQ + qb * 256) * LDMIX + h * HD);
    r.P0 = qb * 256;
    return r;
}
__device__ __forceinline__ fox::BlockRef fox_item(int L) { return fox_ref(L & 31, 15 - (L >> 5)); }
__device__ __forceinline__ int fox_fetch(Frame& F) {
    __syncthreads();
    if (F.tid == 0) F.MISC[16] = __hip_atomic_fetch_add(F.ctl + CW_QUEUE, 1u, RLX_AGENT);
    __syncthreads();
    return (int)F.MISC[16];
}
__device__ __forceinline__ void p5_fox(Frame& F, char* lds) {
    constexpr int TOTAL = BATCH * NH * (SEQ / 256);
    int cur = fox_fetch(F); if (cur >= TOTAL) return;
    int nxt = fox_fetch(F);
    const fox::Bases Bs{(const bf16*)(F.ws + WS_P), (const bf16*)(F.ws + WS_KX), (bf16*)(F.ws + WS_MIX)};
    fox::Seam S;
    { const fox::BlockRef c0 = fox_item(cur); fox::fox_prime<NPP, LDMIX>(Bs, c0, lds, S); }
    for (;;) {
        const bool has_next = nxt < TOTAL;
        const fox::BlockRef c = fox_item(cur), nx = fox_item(has_next ? nxt : cur);
        fox::fox_block<NPP, LDMIX>(Bs, c, nx, lds, S);
        if (!has_next) break;
        cur = nxt; nxt = fox_fetch(F);
    }
}
__device__ __forceinline__ void p6_gdn_out(Frame& F) {
    const int gw = F.vcu * NWAVES + F.wave, NGW = F.G * NWAVES;
    const bf16* P = (const bf16*)(F.ws + WS_P); bf16* MIX = (bf16*)(F.ws + WS_MIX); const bf16* GO = (const bf16*)(F.ws + WS_GO);
    const int l16 = F.lane & 15, sub = F.lane >> 4;
    for (int row = gw; row < M; row += NGW) {
        const int b = row / SEQ, t = row % SEQ;
#pragma unroll
        for (int it = 0; it < 4; ++it) {
            const int h = it * 4 + sub;
            const v4u ow = *(const GAS v4u*)(GO + ((size_t)(b * NH + h) * SEQ + t) * HD + l16 * 8);
            const f32x4 o0 = {bflo(ow.x), bfhi(ow.x), bflo(ow.y), bfhi(ow.y)}, o1 = {bflo(ow.z), bfhi(ow.z), bflo(ow.w), bfhi(ow.w)};
            const v4u zw = *(const GAS v4u*)(P + (size_t)row * NPP + PC_Z + h * HD + l16 * 8);
            float ss = (o0.x * o0.x + o0.y * o0.y) + (o0.z * o0.z + o0.w * o0.w) + (o1.x * o1.x + o1.y * o1.y) + (o1.z * o1.z + o1.w * o1.w);
            const float rstd = 1.0f / sqrtf(sum16(ss) * (1.0f / HD) + EPS);
            const float* gn = F.gdn_norm_w + l16 * 8; const f32x4 g0 = *(const f32x4*)gn, g1 = *(const f32x4*)(gn + 4);
            v4u w;
            w.x = pk2(o0.x * rstd * g0.x * siluf_(bflo(zw.x)), o0.y * rstd * g0.y * siluf_(bfhi(zw.x)));
            w.y = pk2(o0.z * rstd * g0.z * siluf_(bflo(zw.y)), o0.w * rstd * g0.w * siluf_(bfhi(zw.y)));
            w.z = pk2(o1.x * rstd * g1.x * siluf_(bflo(zw.z)), o1.y * rstd * g1.y * siluf_(bfhi(zw.z)));
            w.w = pk2(o1.z * rstd * g1.z * siluf_(bflo(zw.w)), o1.w * rstd * g1.w * siluf_(bfhi(zw.w)));
            *(GAS v4u*)(MIX + (size_t)row * LDMIX + FOXW + h * HD + l16 * 8) = w;
        }
    }
}

typedef short gbf16x8 __attribute__((ext_vector_type(8)));
typedef float gf32x16 __attribute__((ext_vector_type(16)));
typedef float gf32x2 __attribute__((ext_vector_type(2))); typedef __bf16 gbf16x2 __attribute__((ext_vector_type(2)));
__device__ __forceinline__ unsigned gcvtpk(float lo, float hi) { gf32x2 v = {lo, hi}; gbf16x2 b = __builtin_convertvector(v, gbf16x2); return __builtin_bit_cast(unsigned, b); }
__device__ __forceinline__ gbf16x8 gpack8(f32x4 a, f32x4 b) { v4u w = {gcvtpk(a[0], a[1]), gcvtpk(a[2], a[3]), gcvtpk(b[0], b[1]), gcvtpk(b[2], b[3])}; return __builtin_bit_cast(gbf16x8, w); }
__device__ __forceinline__ int gcrow(int r, int hi) { return (r & 3) + 8 * (r >> 2) + 4 * hi; }
__device__ __forceinline__ float gbf(unsigned short h) { return __builtin_bit_cast(float, (unsigned)h << 16); }
constexpr int GP_TAB = 0, GP_AMAT = 2048, GP_TB = GP_AMAT + 17408, GP_TILES = GP_TB + 9216, GP_TS = 272, GP_TILE = 64 * GP_TS, GP_SET = 3 * GP_TILE;
constexpr int GP_CW = GP_TILES + 2 * GP_SET;
static_assert(GP_CW + 6144 <= PHASE_LDS, "chunk-prep LDS map");
__device__ __forceinline__ void gp_tables(Frame& F, int cidx, LAS float* Gs, int lane) {
    const float* GG = (const float*)(F.ws + WS_GG); const float* GB = (const float*)(F.ws + WS_GB); float* GT = (float*)(F.ws + WS_GT);
    const size_t tok0 = (size_t)(cidx >> 6) * SEQ + (cidx & 63) * 64;
    const float gi = GG[tok0 + lane], bi = GB[tok0 + lane];
    float G = gi;
#pragma unroll
    for (int o = 1; o < 64; o <<= 1) { const float u = __shfl_up(G, o); if (lane >= o) G += u; }
    const float G63 = __shfl(G, 63);
    Gs[lane] = G; Gs[64 + lane] = bi; Gs[128 + lane] = __expf(G); Gs[192 + lane] = __expf(G63 - G);
    if (lane == 63) GT[cidx] = __expf(G);
    const int h = (cidx >> 6) & 15; LAS float* cwl = (LAS float*)(F.lds + GP_CW);
#pragma unroll
    for (int r = 0; r < 12; ++r) { const int type = r >> 2, tap = r & 3;
        const float* src = F.gdn_conv_w + (size_t)tap * 6144 + type * GDNW + h * HD + 2 * lane;
        cwl[r * 128 + 2 * lane] = src[0]; cwl[r * 128 + 2 * lane + 1] = src[1]; }
}
template <int NW> struct GpTaps { static constexpr int NP_ = (192 + 4 * NW - 1) / (4 * NW); v4u xw[NP_][4]; };
template <int NW>
__device__ __forceinline__ void gp_stage0_load(Frame& F, int cidx, int w, int lane, GpTaps<NW>& tp) {

    constexpr int NP_ = (192 + 4 * NW - 1) / (4 * NW);
    const bf16* P = (const bf16*)(F.ws + WS_P);
    const int c = lane & 15, sub = lane >> 4;
    const int bh = cidx >> 6, n = cidx & 63, b = bh >> 4, h = bh & 15;
#pragma unroll
    for (int it = 0; it < NP_; ++it) {
        int pi = it * 4 * NW + 4 * w + sub; if (pi > 191) pi = 191;
        const int type = pi >> 6, i = pi & 63, t = n * 64 + i;
        const bf16* prow = P + (size_t)(b * SEQ + t) * NPP + PC_G + type * GDNW + h * HD + c * 8;
#pragma unroll
        for (int tap = 0; tap < 4; ++tap) { const int dt = 3 - tap; const bool ok = t - dt >= 0;
            tp.xw[it][tap] = *(const GAS v4u*)(prow - (size_t)(ok ? dt : 0) * NPP);
            if (!ok) tp.xw[it][tap] = (v4u){0u, 0u, 0u, 0u}; }
    }
}
template <int NW>
__device__ __forceinline__ void gp_stage0_compute(Frame& F, int cidx, const LAS float* Gs, LAS unsigned char* tiles, int w, int lane, const GpTaps<NW>& tp) {

    constexpr int NP_ = (192 + 4 * NW - 1) / (4 * NW);
    const int c = lane & 15, sub = lane >> 4;
    const int bh = cidx >> 6, n = cidx & 63, b = bh >> 4, h = bh & 15;
    unsigned char* CH = F.ws + WS_CH + (size_t)cidx * CH_BYTES;
    const LAS float* cwl = (const LAS float*)(F.lds + GP_CW);
#pragma unroll
    for (int it = 0; it < NP_; ++it) {
        const int pi = it * 4 * NW + 4 * w + sub;
        if (pi < 192) {
            const int type = pi >> 6, i = pi & 63;
            float acc[8];
#pragma unroll
            for (int e = 0; e < 8; ++e) acc[e] = 0.f;
#pragma unroll
            for (int tap = 0; tap < 4; ++tap) {
                const v4u xv = tp.xw[it][tap];
                const LAS float* cw = cwl + (type * 4 + tap) * 128 + c * 8;
                const f32x4 c0 = *(const LAS f32x4*)cw, c1 = *(const LAS f32x4*)(cw + 4);
                acc[0] += bflo(xv.x) * c0.x; acc[1] += bfhi(xv.x) * c0.y; acc[2] += bflo(xv.y) * c0.z; acc[3] += bfhi(xv.y) * c0.w;
                acc[4] += bflo(xv.z) * c1.x; acc[5] += bfhi(xv.z) * c1.y; acc[6] += bflo(xv.w) * c1.z; acc[7] += bfhi(xv.w) * c1.w;
            }
            float ss = 0.f;
#pragma unroll
            for (int e = 0; e < 8; ++e) { acc[e] = siluf_(acc[e]); ss += acc[e] * acc[e]; }
            ss = sum16(ss);
            float sc = 1.0f;
            if (type < 2) sc = __builtin_amdgcn_rsqf(ss + EPS);
            if (type == 0) sc *= 0.08838834764831845f;
#pragma unroll
            for (int e = 0; e < 8; ++e) acc[e] *= sc;
            const v4u o = {gcvtpk(acc[0], acc[1]), gcvtpk(acc[2], acc[3]), gcvtpk(acc[4], acc[5]), gcvtpk(acc[6], acc[7])};
            *(LAS v4u*)(tiles + type * GP_TILE + i * GP_TS + c * 16) = o;
            if (type == 0) {
                const float e_ = Gs[128 + i];
                v2u w0 = {gcvtpk(acc[0] * e_, acc[1] * e_), gcvtpk(acc[2] * e_, acc[3] * e_)}, w1 = {gcvtpk(acc[4] * e_, acc[5] * e_), gcvtpk(acc[6] * e_, acc[7] * e_)};
                *(GAS v2u*)(CH + CH_Q + i * RS_W + c * 16) = w0; *(GAS v2u*)(CH + CH_Q + i * RS_W + c * 16 + 8) = w1;
            }
        }
        asm volatile("" ::: "memory");
    }
}
template <int NW>
__device__ __forceinline__ void gp_stage0(Frame& F, int cidx, const LAS float* Gs, LAS unsigned char* tiles, int w, int lane) { GpTaps<NW> tp; gp_stage0_load<NW>(F, cidx, w, lane, tp); gp_stage0_compute<NW>(F, cidx, Gs, tiles, w, lane, tp); }
#ifndef GP_PROBE
#define GP_PROBE 0
#endif
#define GP_BAR() do { asm volatile("s_waitcnt lgkmcnt(0)" ::: "memory"); __builtin_amdgcn_s_barrier(); asm volatile("" ::: "memory"); } while (0)
__device__ __forceinline__ void gdn_chunk_prep(Frame& F) {
    LAS float* Amat = (LAS float*)(F.lds + GP_AMAT);
    LAS bf16* Tb = (LAS bf16*)(F.lds + GP_TB);
    constexpr int TS = GP_TS;
    const int wave = F.wave;
    int cidx = F.vcu; if (cidx >= NCHUNK) return;
    { int tid0 = F.tid; asm volatile("" : "+v"(tid0)); const int lane0 = tid0 & 63;
      if (wave == 0) gp_tables(F, cidx, (LAS float*)(F.lds + GP_TAB), lane0);
      else if (wave == 7) p5_kx(F);
      GP_BAR();
      gp_stage0<8>(F, cidx, (const LAS float*)(F.lds + GP_TAB), F.lds + GP_TILES, wave, lane0);
      GP_BAR(); }
    for (int k = 0; cidx < NCHUNK; cidx += F.G, ++k) {
        int tid_ = F.tid; asm volatile("" : "+v"(tid_));
        const int lane = tid_ & 63, r32 = lane & 31, hi = lane >> 5;
        const int cur = k & 1, ncidx = cidx + F.G; const bool has_next = ncidx < NCHUNK;
        const LAS float* Gs = (const LAS float*)(F.lds + GP_TAB + cur * 1024); const LAS float* Bs = Gs + 64; const LAS float* EGs = Gs + 128; const LAS float* EGTs = Gs + 192;
        LAS unsigned char* qs = F.lds + GP_TILES + cur * GP_SET; LAS unsigned char* ks = qs + GP_TILE; LAS unsigned char* vs = ks + GP_TILE;
        unsigned char* CH = F.ws + WS_CH + (size_t)cidx * CH_BYTES;
        for (int rep_ = 0; rep_ < ((GP_PROBE & 1) ? 2 : 1); ++rep_)
        if (wave < 6) {
            const int typ = wave / 3, blk = wave % 3, I = blk ? 1 : 0, J = blk == 2 ? 1 : 0;
            const LAS unsigned char* Ap = (typ ? qs : ks) + (32 * I + r32) * TS + hi * 16;
            const LAS unsigned char* Bp = ks + (32 * J + r32) * TS + hi * 16;
            gf32x16 acc = {};
#pragma unroll
            for (int kk = 0; kk < 8; ++kk) {
                const gbf16x8 a = *(const LAS gbf16x8*)(Ap + kk * 32), bq = *(const LAS gbf16x8*)(Bp + kk * 32);
                acc = __builtin_amdgcn_mfma_f32_32x32x16_bf16(a, bq, acc, 0, 0, 0);
            }
            const int j = 32 * J + r32; const float Gj = Gs[j];
#pragma unroll
            for (int q = 0; q < 16; ++q) {
                const int i = 32 * I + gcrow(q, hi);
                const float val = acc[q] * __expf(Gs[i] - Gj);
                if (typ == 0) { if (i > j) Amat[i * 68 + j] = Bs[i] * val; }
                else { *(LAS bf16*)((LAS unsigned char*)Tb + i * RS_K + j * 2) = (bf16)f2bf(i >= j ? val : 0.f); }
            }
        } else {
            const int t = tid_ - 384;
#pragma unroll 4
            for (int ig = 0; ig < 16; ++ig) {
                const float x0 = gbf(*(const LAS bf16*)(ks + (4 * ig) * TS + t * 2)) * EGTs[4 * ig], x1 = gbf(*(const LAS bf16*)(ks + (4 * ig + 1) * TS + t * 2)) * EGTs[4 * ig + 1];
                const float x2 = gbf(*(const LAS bf16*)(ks + (4 * ig + 2) * TS + t * 2)) * EGTs[4 * ig + 2], x3 = gbf(*(const LAS bf16*)(ks + (4 * ig + 3) * TS + t * 2)) * EGTs[4 * ig + 3];
                v2u w = {gcvtpk(x0, x1), gcvtpk(x2, x3)};
                *(GAS v2u*)(CH + CH_KT + t * RS_K + ig * 8) = w;
            }
        }
        GP_BAR();
        if (wave == 0) {
            float T[64];
#pragma unroll
            for (int i = 0; i < 50; i += 2) {
                float a = (i == lane) ? 1.f : 0.f, bq = (i + 1 == lane) ? 1.f : 0.f;
#pragma unroll
                for (int j = 0; j < i; ++j) { a = fmaf(-Amat[i * 68 + j], T[j], a); bq = fmaf(-Amat[(i + 1) * 68 + j], T[j], bq); }
                T[i] = a;
                T[i + 1] = fmaf(-Amat[(i + 1) * 68 + i], a, bq);
                asm volatile("" ::: "memory");
            }
            GP_BAR();
#pragma unroll
            for (int i = 50; i < 64; i += 2) {
                float a = (i == lane) ? 1.f : 0.f, bq = (i + 1 == lane) ? 1.f : 0.f;
#pragma unroll
                for (int j = 0; j < i; ++j) { a = fmaf(-Amat[i * 68 + j], T[j], a); bq = fmaf(-Amat[(i + 1) * 68 + j], T[j], bq); }
                T[i] = a;
                T[i + 1] = fmaf(-Amat[(i + 1) * 68 + i], a, bq);
                asm volatile("" ::: "memory");
            }
#pragma unroll
            for (int i = 0; i < 64; ++i) Tb[i * 72 + lane] = (bf16)f2bf(T[i]);
        } else {
            GpTaps<7> tp;
            gp_stage0_load<7>(F, has_next ? ncidx : cidx, wave - 1, lane, tp);
            if (wave == 1) { if (has_next) gp_tables(F, ncidx, (LAS float*)(F.lds + GP_TAB + (cur ^ 1) * 1024), lane); }
            else {
                const int t = tid_ - 128;
                for (int x = t; x < 544; x += 384) *(GAS v4u*)(CH + CH_AQ + x * 16) = *(const LAS v4u*)((LAS unsigned char*)Tb + x * 16);
                if (k > 0) { unsigned char* CHp = F.ws + WS_CH + (size_t)(cidx - F.G) * CH_BYTES; const LAS unsigned char* wi = F.lds + GP_TILES + (cur ^ 1) * GP_SET;
                    for (int x = t; x < 1056; x += 384) *(GAS v4u*)(CHp + CH_W + x * 16) = *(const LAS v4u*)(wi + x * 16); }
            }
            GP_BAR();
            if (has_next) gp_stage0_compute<7>(F, ncidx, (const LAS float*)(F.lds + GP_TAB + (cur ^ 1) * 1024), F.lds + GP_TILES + (cur ^ 1) * GP_SET, wave - 1, lane, tp);
        }
        GP_BAR();
        for (int rep_ = 0; rep_ < ((GP_PROBE & 4) ? 2 : 1); ++rep_) {
            const int nb = wave & 3, isU = wave >> 2;
            const LAS unsigned char* src = (isU ? vs : ks) + (32 * nb + r32) * 2;
            gf32x16 acc0 = {}, acc1 = {};
#pragma unroll
            for (int kk = 0; kk < 4; ++kk) {
                float x[8];
#pragma unroll
                for (int jj = 0; jj < 8; ++jj) { const int j = 16 * kk + 8 * hi + jj; const float sc = isU ? Bs[j] : Bs[j] * EGs[j]; x[jj] = gbf(*(const LAS bf16*)(src + j * TS)) * sc; }
                const v4u bw = {gcvtpk(x[0], x[1]), gcvtpk(x[2], x[3]), gcvtpk(x[4], x[5]), gcvtpk(x[6], x[7])};
                const gbf16x8 bq = __builtin_bit_cast(gbf16x8, bw);
                const gbf16x8 a0 = *(const LAS gbf16x8*)((LAS unsigned char*)Tb + r32 * 144 + (16 * kk + 8 * hi) * 2);
                const gbf16x8 a1 = *(const LAS gbf16x8*)((LAS unsigned char*)Tb + (32 + r32) * 144 + (16 * kk + 8 * hi) * 2);
                acc0 = __builtin_amdgcn_mfma_f32_32x32x16_bf16(a0, bq, acc0, 0, 0, 0);
                acc1 = __builtin_amdgcn_mfma_f32_32x32x16_bf16(a1, bq, acc1, 0, 0, 0);
            }
            if (isU) {
                float* up = (float*)(F.ws + WS_UC) + ((size_t)(cidx * 2 + 0) * 4 + nb) * 1024 + lane * 16;
#pragma unroll
                for (int v = 0; v < 4; ++v) { *(f32x4*)(up + 4 * v) = (f32x4){acc0[4 * v], acc0[4 * v + 1], acc0[4 * v + 2], acc0[4 * v + 3]};
                                              *(f32x4*)(up + 4096 + 4 * v) = (f32x4){acc1[4 * v], acc1[4 * v + 1], acc1[4 * v + 2], acc1[4 * v + 3]}; }
            } else {
#pragma unroll
                for (int q = 0; q < 16; ++q) { const int i = gcrow(q, hi);
                    *(LAS bf16*)(qs + i * RS_W + (32 * nb + r32) * 2) = (bf16)f2bf(-acc0[q]);
                    *(LAS bf16*)(qs + (32 + i) * RS_W + (32 * nb + r32) * 2) = (bf16)f2bf(-acc1[q]); }
            }
        }
        GP_BAR();
    }
    {
        int tid_ = F.tid; asm volatile("" : "+v"(tid_));
        const int last = cidx - F.G, kl = (last - F.vcu) / F.G;
        unsigned char* CHp = F.ws + WS_CH + (size_t)last * CH_BYTES; const LAS unsigned char* wi = F.lds + GP_TILES + (kl & 1) * GP_SET;
        for (int x = tid_; x < 1056; x += NWAVES * 64) *(GAS v4u*)(CHp + CH_W + x * 16) = *(const LAS v4u*)(wi + x * 16);
    }
}
#undef GP_BAR
__device__ __forceinline__ gbf16x8 gdn_ldfrag(const LAS unsigned char* p) {
    const v2u lo = *(const LAS v2u*)p, hi8 = *(const LAS v2u*)(p + 16);
    const v4u w = {lo.x, lo.y, hi8.x, hi8.y}; return __builtin_bit_cast(gbf16x8, w);
}
__device__ __forceinline__ gbf16x8 gdn_accfrag(const gf32x16& x, int s) {
    const v4u w = {gcvtpk(x[8 * s], x[8 * s + 1]), gcvtpk(x[8 * s + 2], x[8 * s + 3]), gcvtpk(x[8 * s + 4], x[8 * s + 5]), gcvtpk(x[8 * s + 6], x[8 * s + 7])};
    return __builtin_bit_cast(gbf16x8, w);
}
#define GDN_BAR() do { asm volatile("s_waitcnt lgkmcnt(0)" ::: "memory"); __builtin_amdgcn_s_barrier(); asm volatile("" ::: "memory"); } while (0)
__device__ __forceinline__ void gdn_scan(Frame& F, int bh) {
    const int lane = F.lane, wave = F.wave, c = lane & 31, hi = lane >> 5;
    const unsigned char* CHB = F.ws + WS_CH + (size_t)(bh * 64) * CH_BYTES;
    if (wave >= 4) {
        const unsigned char* src = CHB + (wave - 4) * 1024 + lane * 16;
#pragma unroll
        for (int i = 0; i < 15; ++i) __builtin_amdgcn_global_load_lds((const unsigned*)(src + i * 4096), (LAS unsigned*)(F.lds + (i * 4 + (wave - 4)) * 1024), 16, 0, 0);
        asm volatile("s_waitcnt vmcnt(0)" ::: "memory"); GDN_BAR();
        for (int n = 0; n < 64; ++n) {
            if (n + 1 < 64) { const unsigned char* s2 = src + (size_t)(n + 1) * CH_BYTES; const int boff = ((n + 1) & 1) * CH_BYTES;
#pragma unroll
                for (int i = 0; i < 15; ++i) __builtin_amdgcn_global_load_lds((const unsigned*)(s2 + i * 4096), (LAS unsigned*)(F.lds + boff + (i * 4 + (wave - 4)) * 1024), 16, 0, 0); }
            asm volatile("s_waitcnt vmcnt(0)" ::: "memory"); GDN_BAR();
        }
    } else {
        const float* UC = (const float*)(F.ws + WS_UC) + (size_t)(bh * 64) * 8192 + wave * 1024 + lane * 16;
        const float* GT = (const float*)(F.ws + WS_GT) + bh * 64;
        bf16* GO = (bf16*)(F.ws + WS_GO) + (size_t)bh * SEQ * HD + 32 * wave + c;
        const int roW = c * RS_W + hi * 8, roK = c * RS_K + hi * 8;
        gf32x16 S0 = {}, S1 = {}, S2 = {}, S3 = {};
        gbf16x8 Sb00, Sb01, Sb10, Sb11, Sb20, Sb21, Sb30, Sb31;
        Sb00 = (gbf16x8){0, 0, 0, 0, 0, 0, 0, 0}; Sb01 = Sb00; Sb10 = Sb00; Sb11 = Sb00; Sb20 = Sb00; Sb21 = Sb00; Sb30 = Sb00; Sb31 = Sb00;
        float gtn = GT[0];
        gf32x16 Un0 = *(const gf32x16*)UC, Un1 = *(const gf32x16*)(UC + 4096);
        GDN_BAR();
#define LDF(dst, base, o8) const gbf16x8 dst = gdn_ldfrag(Bp + (base) + (o8) * 8)
#define MF(acc, f, bop) acc = __builtin_amdgcn_mfma_f32_32x32x16_bf16(f, bop, acc, 0, 0, 0)
#define SB() __builtin_amdgcn_sched_barrier(0)
        for (int n = 0; n < 64; ++n) {
            const LAS unsigned char* Bp = F.lds + (n & 1) * CH_BYTES;
            const int bW0 = CH_W + roW, bW1 = bW0 + 32 * RS_W, bQ0 = CH_Q + roW, bQ1 = bQ0 + 32 * RS_W, bA0 = CH_AQ + roK, bA1 = bA0 + 32 * RS_K;
            const int bK0 = CH_KT + roK, bK1 = bK0 + 32 * RS_K, bK2 = bK0 + 64 * RS_K, bK3 = bK0 + 96 * RS_K;
            const float gt = gtn;
            gf32x16 V0 = Un0, V1 = Un1, O0 = {}, O1 = {};
            if (n + 1 < 64) { gtn = GT[n + 1]; SB(); Un0 = *(const gf32x16*)(UC + (size_t)(n + 1) * 8192); Un1 = *(const gf32x16*)(UC + (size_t)(n + 1) * 8192 + 4096); }
            SB();
            LDF(w00, bW0, 0); LDF(w01, bW1, 0); LDF(w02, bW0, 4); LDF(w03, bW1, 4); SB();
            LDF(w10, bW0, 8); LDF(w11, bW1, 8); LDF(w12, bW0, 12); LDF(w13, bW1, 12); SB();
            MF(V0, w00, Sb00); MF(V1, w01, Sb00); MF(V0, w02, Sb01); MF(V1, w03, Sb01); SB();
            LDF(w20, bW0, 16); LDF(w21, bW1, 16); LDF(w22, bW0, 20); LDF(w23, bW1, 20); SB();
            MF(V0, w10, Sb10); MF(V1, w11, Sb10); MF(V0, w12, Sb11); MF(V1, w13, Sb11); SB();
            LDF(w30, bW0, 24); LDF(w31, bW1, 24); LDF(w32, bW0, 28); LDF(w33, bW1, 28); SB();
            MF(V0, w20, Sb20); MF(V1, w21, Sb20); MF(V0, w22, Sb21); MF(V1, w23, Sb21); SB();
            LDF(q00, bQ0, 0); LDF(q01, bQ1, 0); LDF(q02, bQ0, 4); LDF(q03, bQ1, 4); SB();
            MF(V0, w30, Sb30); MF(V1, w31, Sb30); MF(V0, w32, Sb31); MF(V1, w33, Sb31); SB();
            LDF(q10, bQ0, 8); LDF(q11, bQ1, 8); LDF(q12, bQ0, 12); LDF(q13, bQ1, 12); SB();
            MF(O0, q00, Sb00); MF(O1, q01, Sb00); MF(O0, q02, Sb01); MF(O1, q03, Sb01); SB();
            LDF(q20, bQ0, 16); LDF(q21, bQ1, 16); LDF(q22, bQ0, 20); LDF(q23, bQ1, 20); SB();
            MF(O0, q10, Sb10); MF(O1, q11, Sb10); MF(O0, q12, Sb11); MF(O1, q13, Sb11); S0 = S0 * gt; S1 = S1 * gt; SB();
            LDF(q30, bQ0, 24); LDF(q31, bQ1, 24); LDF(q32, bQ0, 28); LDF(q33, bQ1, 28); SB();
            MF(O0, q20, Sb20); MF(O1, q21, Sb20); MF(O0, q22, Sb21); MF(O1, q23, Sb21); S2 = S2 * gt; S3 = S3 * gt; SB();
            LDF(x0, bA0, 0); LDF(x1, bA1, 0); LDF(x2, bA1, 8); LDF(x3, bA0, 4); SB();
            MF(O0, q30, Sb30); MF(O1, q31, Sb30); MF(O0, q32, Sb31); MF(O1, q33, Sb31); SB();
            const gbf16x8 Vb00 = gdn_accfrag(V0, 0), Vb01 = gdn_accfrag(V0, 1), Vb10 = gdn_accfrag(V1, 0), Vb11 = gdn_accfrag(V1, 1);
            LDF(x4, bA1, 4); LDF(x5, bA1, 12); LDF(k00, bK0, 0); LDF(k01, bK1, 0); SB();
            MF(O0, x0, Vb00); MF(O1, x1, Vb00); MF(O1, x2, Vb10); MF(O0, x3, Vb01); SB();
            LDF(k02, bK2, 0); LDF(k03, bK3, 0); LDF(k10, bK0, 4); LDF(k11, bK1, 4); SB();
            MF(O1, x4, Vb01); MF(O1, x5, Vb11);
            MF(S0, k00, Vb00); MF(S1, k01, Vb00); SB();
            LDF(k12, bK2, 4); LDF(k13, bK3, 4); LDF(k20, bK0, 8); LDF(k21, bK1, 8); SB();
            MF(S2, k02, Vb00); MF(S3, k03, Vb00); MF(S0, k10, Vb01); MF(S1, k11, Vb01); SB();
            LDF(k22, bK2, 8); LDF(k23, bK3, 8); LDF(k30, bK0, 12); LDF(k31, bK1, 12); SB();
            MF(S2, k12, Vb01); MF(S3, k13, Vb01); MF(S0, k20, Vb10); MF(S1, k21, Vb10); SB();
            LDF(k32, bK2, 12); LDF(k33, bK3, 12); SB();
            MF(S2, k22, Vb10); MF(S3, k23, Vb10); MF(S0, k30, Vb11); MF(S1, k31, Vb11); SB();
            MF(S2, k32, Vb11); MF(S3, k33, Vb11); SB();
            bf16* op = GO + (size_t)(n * 64) * HD;
#pragma unroll
            for (int q = 0; q < 16; ++q) { const int i = gcrow(q, hi); op[(size_t)i * HD] = (bf16)gcvtpk(O0[q], O0[q]); op[(size_t)(32 + i) * HD] = (bf16)gcvtpk(O1[q], O1[q]); }
            Sb00 = gdn_accfrag(S0, 0); Sb01 = gdn_accfrag(S0, 1); Sb10 = gdn_accfrag(S1, 0); Sb11 = gdn_accfrag(S1, 1);
            Sb20 = gdn_accfrag(S2, 0); Sb21 = gdn_accfrag(S2, 1); Sb30 = gdn_accfrag(S3, 0); Sb31 = gdn_accfrag(S3, 1);
            GDN_BAR();
        }
#undef LDF
#undef MF
#undef SB
    }
}
#undef GDN_BAR
struct Args { const float* in[18]; float* out; unsigned char* ws; int ph_lo, ph_hi; };
__global__ void __launch_bounds__(NWAVES * 64, 2) hyb_fwd(Args args) {
    extern __shared__ __attribute__((aligned(16))) unsigned char lds[];
    Frame F;
    F.lds = (LAS unsigned char*)lds;
    F.MISC = (volatile LAS unsigned*)(F.lds + MISC_OFF);
    F.tid = threadIdx.x; F.lane = F.tid & 63; F.wave = __builtin_amdgcn_readfirstlane(F.tid >> 6);
    F.G = gridDim.x; { const int bx = blockIdx.x; F.vcu = (F.G % 8 == 0) ? (bx % 8) * (F.G / 8) + bx / 8 : bx; }
    F.ws = args.ws; F.ctl = (gu32*)(args.ws + WS_CTL);
    F.x = args.in[0]; F.c = args.in[1]; F.w_ada = args.in[2]; F.b_ada = args.in[3]; F.norm1_g = args.in[4]; F.w_in = args.in[5]; F.fox_q_norm = args.in[6]; F.fox_k_norm = args.in[7];
    F.fox_f_bias = args.in[8]; F.gdn_conv_w = args.in[9]; F.gdn_a_log = args.in[10]; F.gdn_dt_bias = args.in[11]; F.gdn_norm_w = args.in[12]; F.w_out = args.in[13]; F.norm2_g = args.in[14];
    F.w_gate = args.in[15]; F.w_up = args.in[16]; F.w_down = args.in[17]; F.out = args.out;
    for (int u = F.tid; u < (LDS_BYTES - LDSCTL_OFF) / 4; u += NWAVES * 64) ((LAS unsigned*)(F.lds + LDSCTL_OFF))[u] = 0u;
    __syncthreads();
    const int lo = args.ph_lo, hi = args.ph_hi;
    const bool fusedrun = (hi - lo) > 1;
    XcdBarrier bar; bar.bar = (unsigned*)(F.ctl + CW_BAR); bar.x = 0; bar.st = nullptr;
    if (fusedrun) bar = xcd_barrier_post((unsigned*)(F.ctl + CW_BAR), F.MISC + 8);
#ifndef PHASE_MASK
#define PHASE_MASK 0xfff
#endif
#define IN(k) (((PHASE_MASK >> (k)) & 1) && lo <= (k) && (k) < hi)
#define REFRESH() do { int t_ = threadIdx.x; asm volatile("" : "+v"(t_)); F.tid = t_; F.lane = t_ & 63; F.wave = __builtin_amdgcn_readfirstlane(t_ >> 6); } while (0)
#define SEAM(k) do { if (IN(k) && IN((k) + 1)) xcd_barrier(bar); } while (0)
    bf16* H = (bf16*)(args.ws + WS_H); bf16* P = (bf16*)(args.ws + WS_P); bf16* MIX = (bf16*)(args.ws + WS_MIX); bf16* HID = (bf16*)(args.ws + WS_HID); bf16* X1 = (bf16*)(args.ws + WS_X1);
    const float* MOD = (const float*)(args.ws + WS_MOD);

#ifndef REP_MASK
#define REP_MASK 0
#endif
#ifndef REPN
#define REPN 1
#endif
#define REP(k) (((REP_MASK >> (k)) & 1) && fusedrun)
#ifndef PRE_EPI
#define PRE_EPI EpiBf16<0>
#define PRE_EPI_INIT {P, NPP, nullptr, 0, 0, 1.f}
#endif
#ifndef PRE_K
#define PRE_K 0
#endif
#ifndef PRE_K10
#define PRE_K10 0
#endif
#ifndef SIDE_REP
#define SIDE_REP 1
#endif
#define LATE_OK ((int)F.G >= BATCH * NH + P6_CONV_WGS + P6_ADA_WGS)
#define PH0 { p0_ada<false>(F, 0, LATE_OK ? 2 * (DM / 256) : NMOD / 256, F.vcu, F.G); p0_weights<false>(F, 0, LATE_OK ? P0_ITEMS_IN : P0_ITEMS_ALL - P0_ITEMS_DOWN, F.vcu, F.G); }
#define PH1 { p1_modreduce(F, 0, LATE_OK ? 2 * DM : NMOD); }
#define PH2 { norm_mod_stage(F, F.norm1_g, 0, 1); REFRESH(); norm_mod_rows(F, F.x, LDH); }
#define PH3 { if (PRE_K > 0) { pg8::Gemm g{H, (const bf16*)(args.ws + WS_WIN), M, NP, PRE_K, LDH}; pg8::StaticOrder S; S.init(M, NP, F.G, (int)blockIdx.x); pg8::PRE_EPI E PRE_EPI_INIT; \
              pg8::gemm_phase<pg8::PRE_EPI, pg8::StaticOrder, PG8_ALIGN, PG8_SP2>(F.lds + RING_OFF, g, S, E); __syncthreads(); REFRESH(); } \
              { pg8::Gemm g{H, (const bf16*)(args.ws + WS_WIN), M, NP, DM, LDH}; pg8::StaticOrder S; S.init(M, NP, F.G, (int)blockIdx.x); pg8::EpiBf16QKL E{P, NPP, F.fox_q_norm, F.fox_k_norm, (LAS float*)(F.lds + RING_OFF + RING_BYTES)}; \
              pg8::gemm_phase<pg8::EpiBf16QKL, pg8::StaticOrder, PG8_ALIGN, PG8_SP2>(F.lds + RING_OFF, g, S, E); }                       \
              for (int r_ = 0; r_ < SIDE_REP; ++r_) { __syncthreads(); REFRESH(); \
              { pg8::Gemm g{H, (const bf16*)(args.ws + WS_WIN) + (size_t)NP * LDWIN, 8 * M, 512, DM / 8, DM / 8}; pg8::StaticOrder S; S.init(8 * M, 512, F.G, (int)blockIdx.x); pg8::EpiScalars E{(float*)(args.ws + WS_FLS), (float*)(args.ws + WS_GG), (float*)(args.ws + WS_GB), F.fox_f_bias, F.gdn_a_log, F.gdn_dt_bias, SEQ, NH}; \
              pg8::gemm_phase<pg8::EpiScalars, pg8::StaticOrder, PG8_ALIGN, PG8_SP2>(F.lds + RING_OFF, g, S, E); } } }
#define PH4 { }
#define PH5 { gdn_chunk_prep(F); }
#define PH6 { if (blockIdx.x < BATCH * NH) { gdn_scan(F, (int)blockIdx.x); VM_WAIT(); __syncthreads(); if (REP(12)) { REFRESH(); gdn_scan(F, (int)blockIdx.x); VM_WAIT(); __syncthreads(); } REFRESH(); } \
              else if (!LATE_OK) { } \
              else if ((int)blockIdx.x >= BATCH * NH + P6_CONV_WGS && (int)blockIdx.x < BATCH * NH + P6_CONV_WGS + P6_ADA_WGS) { p0_ada<true>(F, 2 * (DM / 256), NMOD / 256, (int)blockIdx.x - BATCH * NH - P6_CONV_WGS, P6_ADA_WGS); VM_WAIT(); __syncthreads(); REFRESH(); } \
              else if ((int)blockIdx.x < BATCH * NH + P6_CONV_WGS) { p0_weights<true>(F, P0_ITEMS_IN, P0_ITEMS_ALL - P0_ITEMS_DOWN, (int)blockIdx.x - BATCH * NH, P6_CONV_WGS); VM_WAIT(); __syncthreads(); REFRESH(); } \
              p5_fox(F, (char*)lds + RING_OFF); }
#define PH7 { if (LATE_OK) p1_modreduce(F, 2 * DM, NMOD); p6_gdn_out(F); }
#define PH8 { pg8::Gemm g{MIX, (const bf16*)(args.ws + WS_WOUT), M, DM, DM, LDMIX}; pg8::StaticOrder S; S.init(M, DM, F.G, (int)blockIdx.x); pg8::EpiResGateToBf16 E{F.x, X1, DM, MOD + 2 * DM, NMOD, SEQ}; \
              pg8::gemm_phase<pg8::EpiResGateToBf16, pg8::StaticOrder, PG8_ALIGN, PG8_SP2>(F.lds + RING_OFF, g, S, E); }
#define PH9 { norm_mod_stage(F, F.norm2_g, 3, 4); REFRESH(); norm_mod_rows_b16(F, X1, LDH2); }
#define PH10 { if (PRE_K10 > 0) { pg8::Gemm g{H, (const bf16*)(args.ws + WS_WGU), M, 2 * FF, PRE_K10, LDH2}; pg8::StaticOrder S; S.init(M, 2 * FF, F.G, (int)blockIdx.x); pg8::EpiSwiGLU E{HID, FF}; \
               pg8::gemm_phase<pg8::EpiSwiGLU, pg8::StaticOrder, PG8_ALIGN, PG8_SP2>(F.lds + RING_OFF, g, S, E); __syncthreads(); REFRESH(); } \
                pg8::Gemm g{H, (const bf16*)(args.ws + WS_WGU), M, 2 * FF, DM, LDH2}; pg8::StaticOrder S; S.init(M, 2 * FF, F.G, (int)blockIdx.x); pg8::EpiSwiGLU E{HID, FF}; \
               pg8::gemm_phase<pg8::EpiSwiGLU, pg8::StaticOrder, PG8_ALIGN, PG8_SP2>(F.lds + RING_OFF, g, S, E); \
               { const int nwg_ = (M / 256) * (2 * FF / 256), rem_ = nwg_ % F.G;            \
                 if ((int)blockIdx.x >= rem_) { REFRESH(); p0_weights<true>(F, P0_ITEMS_ALL - P0_ITEMS_DOWN, P0_ITEMS_ALL, (int)blockIdx.x - rem_, F.G - rem_); } } }
#define PH11 { pg8::Gemm g{HID, (const bf16*)(args.ws + WS_WD), M, DM, FF, FF}; pg8::StaticOrder S; S.init(M, DM, F.G, (int)blockIdx.x); pg8::EpiResGateFromBf16 E{X1, F.out, DM, MOD + 5 * DM, NMOD, SEQ}; \
               pg8::gemm_phase<pg8::EpiResGateFromBf16, pg8::StaticOrder, PG8_ALIGN, PG8_SP2>(F.lds + RING_OFF, g, S, E); }
#define PHASE(k, BODY) if (IN(k)) { REFRESH(); BODY if (REP(k)) { for (int rep_ = 0; rep_ < REPN; ++rep_) { xcd_barrier(bar); REFRESH(); BODY } } SEAM(k); }
    PHASE(0, PH0) PHASE(1, PH1) PHASE(2, PH2)
    if (IN(3)) { REFRESH(); PH3 if (REP(3)) { for (int rep_ = 0; rep_ < REPN; ++rep_) { xcd_barrier(bar); REFRESH(); PH3 } } if (IN(5)) xcd_barrier(bar); }
    PHASE(5, PH5) PHASE(6, PH6) PHASE(7, PH7) PHASE(8, PH8) PHASE(9, PH9) PHASE(10, PH10)
    if (IN(11)) { REFRESH(); PH11 }
#undef IN
#undef REFRESH
#undef SEAM
}

extern "C" void kernel_launch(void* const* d_in, const int* in_sizes, int n_in, void* d_out, int out_size, void* d_ws, size_t ws_size, hipStream_t stream) {
    static int grid = 0;
    if (grid == 0) {
        if (n_in != 18 || in_sizes[0] != M * DM || out_size != M * DM || ws_size < WS_END) { fprintf(stderr, "kernel_launch: shape/workspace mismatch (n_in %d, in0 %d, out %d, ws %zu < %zu); nothing launched\n", n_in, n_in > 0 ? in_sizes[0] : -1, out_size, ws_size, (size_t)WS_END); grid = -1; return; }
        int dev = 0, cus = 0, per_cu = 0;
        if (hipGetDevice(&dev) != hipSuccess || hipDeviceGetAttribute(&cus, hipDeviceAttributeMultiprocessorCount, dev) != hipSuccess) { grid = -1; return; }
        if (hipFuncSetAttribute((const void*)hyb_fwd, hipFuncAttributeMaxDynamicSharedMemorySize, LDS_BYTES) != hipSuccess) { fprintf(stderr, "kernel_launch: hipFuncSetAttribute failed\n"); grid = -1; return; }
        if (hipOccupancyMaxActiveBlocksPerMultiprocessor(&per_cu, (const void*)hyb_fwd, NWAVES * 64, LDS_BYTES) != hipSuccess || per_cu < 1)
            fprintf(stderr, "kernel_launch: note: occupancy query reports %d workgroups per CU\n", per_cu);
        (void)hipGetLastError();
        grid = cus;
    }
    if (grid < 0) return;
    if (hipMemsetAsync((char*)d_ws + WS_CTL, 0, CTL_ZERO_BYTES, stream) != hipSuccess) { fprintf(stderr, "kernel_launch: hipMemsetAsync failed\n"); return; }
    Args a{};
    for (int i = 0; i < 18; ++i) a.in[i] = (const float*)d_in[i];
    a.out = (float*)d_out; a.ws = (unsigned char*)d_ws;
#if MK_ONE_LAUNCH
    a.ph_lo = 0; a.ph_hi = N_PHASES;
    hipLaunchKernelGGL(hyb_fwd, dim3(grid), dim3(NWAVES * 64), LDS_BYTES, stream, a);
#else
    for (int ph = 0; ph < N_PHASES; ++ph) {
        a.ph_lo = ph; a.ph_hi = ph + 1;
        hipLaunchKernelGGL(hyb_fwd, dim3(grid), dim3(NWAVES * 64), LDS_BYTES, stream, a);
    }
#endif
    const hipError_t le = hipPeekAtLastError();
    if (le != hipSuccess) fprintf(stderr, "kernel_launch: launch failed: %s\n", hipGetErrorName(le));
}
```

```cpp
#include <hip/hip_runtime.h>
#include <cstdio>
#include <cstdint>
namespace pg8 {
#define PG8_LAS __attribute__((address_space(3)))
typedef unsigned short bf16_t;
typedef short bf16x8 __attribute__((ext_vector_type(8)));
typedef float f32x4 __attribute__((ext_vector_type(4)));
typedef unsigned u32x4 __attribute__((ext_vector_type(4)));
constexpr int BM = 256, BK = 64, HALF = 128, HTB = HALF * BK * 2  , STAGE_BYTES = 8 * HTB, NXCD = 8, WGM = 8;

__host__ __device__ __forceinline__ int lds_byte(int r, int c) { const int st = (r >> 4) * 2 + (c >> 5), rr = r & 15, cc = c & 31, ob = rr * 64 + cc * 2; return st * 1024 + (ob ^ (((ob >> 9) & 1) << 5)); }
__host__ __device__ __forceinline__ void stage_rc(int b, int& R, int& C) { const int st = b / 1024, sb = b % 1024, swz = sb ^ (((sb >> 9) & 1) << 5); R = (st >> 1) * 16 + swz / 64; C = (st & 1) * 32 + (swz % 64) / 2; }
__host__ __device__ __forceinline__ int perm32(int rho) { const int n = rho >> 4, i = rho & 15; return 8 * (i >> 2) + 4 * n + (i & 3); }

struct Unit { int pm, pn; };
struct Gemm { const bf16_t* A; const bf16_t* Bt; int M, N, K, ld; };

struct StaticOrder {
    int nM, nN, nwg, G, c;
    __host__ __device__ void init(int M, int N, int G_, int c_) { nM = M / BM; nN = N / BM; nwg = nM * nN; G = G_; c = c_; }
    __host__ __device__ bool next(int i, Unit& u) const {
        const long L = (long)i * G + c; if (L >= nwg) return false;
        int wgid = (int)L; { const int q = nwg / NXCD, r = nwg % NXCD, xcd = wgid % NXCD, off = wgid / NXCD; wgid = (xcd < r ? xcd * (q + 1) : r * (q + 1) + (xcd - r) * q) + off; }
        const int nig = WGM * nN, gid = wgid / nig, fm = gid * WGM, gsz = (nM - fm) < WGM ? (nM - fm) : WGM;
        u.pm = fm + ((wgid % nig) % gsz); u.pn = (wgid % nig) / gsz; return true;
    }
    __device__ __forceinline__ void a_ready(const Unit&) const {}
    __device__ __forceinline__ void done(const Unit&) const {}
};

__device__ __forceinline__ unsigned cvt_pk_bf16(float lo, float hi) { unsigned r; asm volatile("v_cvt_pk_bf16_f32 %0, %1, %2" : "=v"(r) : "v"(lo), "v"(hi)); return r; }
typedef float f32x2 __attribute__((ext_vector_type(2)));
__device__ __forceinline__ f32x2 gelu_pk(f32x2 v) {
    const f32x2 av = __builtin_elementwise_abs(v), d = av * 0.2316418882f + 1.0f;
    f32x2 t; t.x = __builtin_amdgcn_rcpf(d.x); t.y = __builtin_amdgcn_rcpf(d.y);
    f32x2 q = t * 0.5307027145f + (-0.7265760135f); q = q * t + 0.7107068705f; q = q * t + (-0.142248368f); q = q * t + 0.127414796f; q = q * t;
    const f32x2 s = (v * v) * (-0.72134752044f);
    f32x2 e; e.x = __builtin_amdgcn_exp2f(s.x); e.y = __builtin_amdgcn_exp2f(s.y);
    const f32x2 m = v * (q * e), r = v - m;
    f32x2 o; o.x = v.x < 0.f ? m.x : r.x; o.y = v.y < 0.f ? m.y : r.y; return o;
}

template <int ACT  > struct EpiBf16 {
    static constexpr bool PERM = true, AFTER_DRAIN = false; static_assert(ACT == 0 || ACT == 1, "EpiBf16: ACT is 0 (none) or 1 (gelu_pk)");
    bf16_t* O; int ldc; const float* bias; int split_cols; size_t split_stride; float scale0;
    __device__ __forceinline__ void operator()(const f32x4 (&acc)[2][2][4][2], const Unit& u, int wr, int wc, int fr, int fq) const {
        const int row0 = u.pm * BM + wr * 64 + fr; int colt = u.pn * BM; bf16_t* base = O;
        float sc = 1.f; if (split_cols) { const int t = colt / split_cols; base += (size_t)t * split_stride; colt -= t * split_cols; if (t == 0) sc = scale0; }
        const int col0 = colt + wc * 32 + 8 * fq, bcol0 = u.pn * BM + wc * 32 + 8 * fq;
        f32x4 bv[2][2];
#pragma unroll
        for (int bj = 0; bj < 2; ++bj)
#pragma unroll
            for (int n = 0; n < 2; ++n) bv[bj][n] = bias ? *(const f32x4*)(bias + bcol0 + bj * HALF + 4 * n) : (f32x4){0.f, 0.f, 0.f, 0.f};
#pragma unroll
        for (int ai = 0; ai < 2; ++ai)
#pragma unroll
            for (int m = 0; m < 4; ++m) { bf16_t* rowp = base + (size_t)(row0 + ai * HALF + m * 16) * ldc + col0;
#pragma unroll
                for (int bj = 0; bj < 2; ++bj) { f32x4 v0 = acc[ai][bj][m][0] + bv[bj][0], v1 = acc[ai][bj][m][1] + bv[bj][1];
                    if (ACT == 1) { f32x2 a = gelu_pk((f32x2){v0[0], v0[1]}), b = gelu_pk((f32x2){v0[2], v0[3]}), c = gelu_pk((f32x2){v1[0], v1[1]}), d = gelu_pk((f32x2){v1[2], v1[3]});
                        v0 = (f32x4){a.x, a.y, b.x, b.y}; v1 = (f32x4){c.x, c.y, d.x, d.y}; }
                    v0 = v0 * sc; v1 = v1 * sc; u32x4 w; w.x = cvt_pk_bf16(v0[0], v0[1]); w.y = cvt_pk_bf16(v0[2], v0[3]); w.z = cvt_pk_bf16(v1[0], v1[1]); w.w = cvt_pk_bf16(v1[2], v1[3]);
                    *(u32x4*)(rowp + bj * HALF) = w; } }
    }
};

struct EpiResGate {
    static constexpr bool PERM = false, AFTER_DRAIN = false;
    const float* base; float* out; int ldc; const float* gate; int gate_stride; int rows_per_batch;
    __device__ __forceinline__ void operator()(const f32x4 (&acc)[2][2][4][2], const Unit& u, int wr, int wc, int fr, int fq) const {
        const int col0 = u.pn * BM + wc * 32 + 4 * fq;
        const int b = (u.pm * BM) / rows_per_batch;
        const float* gp = gate + (size_t)b * gate_stride + col0;
        f32x4 gv[2][2];
#pragma unroll
        for (int bj = 0; bj < 2; ++bj)
#pragma unroll
            for (int n = 0; n < 2; ++n) gv[bj][n] = *(const f32x4*)(gp + bj * HALF + n * 16);
        const size_t row0 = (size_t)(u.pm * BM + wr * 64 + fr) * ldc + col0;
        f32x4 bs[2][2][2];
#pragma unroll
        for (int bj = 0; bj < 2; ++bj)
#pragma unroll
            for (int n = 0; n < 2; ++n) bs[0][bj][n] = *(const f32x4*)(base + row0 + bj * HALF + n * 16);
#pragma unroll
        for (int g = 0; g < 8; ++g) { const int ai = g >> 2, m = g & 3; const size_t off = row0 + (size_t)(ai * HALF + m * 16) * ldc;
            if (g < 7) { const size_t offn = row0 + (size_t)(((g + 1) >> 2) * HALF + ((g + 1) & 3) * 16) * ldc;
#pragma unroll
                for (int bj = 0; bj < 2; ++bj)
#pragma unroll
                    for (int n = 0; n < 2; ++n) bs[(g + 1) & 1][bj][n] = *(const f32x4*)(base + offn + bj * HALF + n * 16); }
#pragma unroll
            for (int bj = 0; bj < 2; ++bj)
#pragma unroll
                for (int n = 0; n < 2; ++n) *(f32x4*)(out + off + bj * HALF + n * 16) = bs[g & 1][bj][n] + gv[bj][n] * acc[ai][bj][m][n];
        }
    }
};
struct EpiSwiGLU {
    static constexpr bool PERM = true, AFTER_DRAIN = false;
    bf16_t* O; int ldo;
    __device__ __forceinline__ static float silu_mul(float g, float u) { return g * __builtin_amdgcn_rcpf(1.0f + __builtin_amdgcn_exp2f(-1.4426950408889634f * g)) * u; }
    __device__ __forceinline__ void operator()(const f32x4 (&acc)[2][2][4][2], const Unit& u, int wr, int wc, int fr, int fq) const {
        const int row0 = u.pm * BM + wr * 64 + fr, col0 = u.pn * HALF + wc * 32 + 8 * fq;
#pragma unroll
        for (int ai = 0; ai < 2; ++ai)
#pragma unroll
            for (int m = 0; m < 4; ++m) { bf16_t* rowp = O + (size_t)(row0 + ai * HALF + m * 16) * ldo + col0;
                const f32x4 g0 = acc[ai][0][m][0], g1 = acc[ai][0][m][1], u0 = acc[ai][1][m][0], u1 = acc[ai][1][m][1];
                u32x4 w;
                w.x = cvt_pk_bf16(silu_mul(g0[0], u0[0]), silu_mul(g0[1], u0[1])); w.y = cvt_pk_bf16(silu_mul(g0[2], u0[2]), silu_mul(g0[3], u0[3]));
                w.z = cvt_pk_bf16(silu_mul(g1[0], u1[0]), silu_mul(g1[1], u1[1])); w.w = cvt_pk_bf16(silu_mul(g1[2], u1[2]), silu_mul(g1[3], u1[3]));
                *(u32x4*)rowp = w; }
    }
};
struct EpiSplit {
    static constexpr bool PERM = false, AFTER_DRAIN = false;
    float* SP; int rows;
    __device__ __forceinline__ void operator()(const f32x4 (&acc)[2][2][4][2], const Unit& u, int wr, int wc, int fr, int fq) const {
        if ((((fr >> 2) ^ fq) & 1) != 0) return;
        const int ks = fr & 7, e = fr & 3;
        float* base = SP + (size_t)ks * rows * 64;
#pragma unroll
        for (int ai = 0; ai < 2; ++ai)
#pragma unroll
            for (int m = 0; m < 4; ++m) { const int row_o = 32 * u.pm + 16 * ai + 8 * wr + 2 * m + (fr >> 3);
#pragma unroll
                for (int bj = 0; bj < 2; ++bj)
#pragma unroll
                    for (int n = 0; n < 2; ++n) { const int col_o = 32 * u.pn + 16 * bj + 4 * wc + 2 * n + (fq >> 1);
                        const f32x4 v = acc[ai][bj][m][n];
                        base[(size_t)row_o * 64 + col_o] = e == 0 ? v[0] : (e == 1 ? v[1] : (e == 2 ? v[2] : v[3])); } }
    }
};
struct EpiResGateToBf16 {
    static constexpr bool PERM = true, AFTER_DRAIN = false;
    const float* base; bf16_t* out; int ldc; const float* gate; int gate_stride; int rows_per_batch;
    __device__ __forceinline__ void operator()(const f32x4 (&acc)[2][2][4][2], const Unit& u, int wr, int wc, int fr, int fq) const {
        const int col0 = u.pn * BM + wc * 32 + 8 * fq;
        const int b = (u.pm * BM) / rows_per_batch;
        const float* gp = gate + (size_t)b * gate_stride + col0;
        f32x4 gv[2][2];
#pragma unroll
        for (int bj = 0; bj < 2; ++bj)
#pragma unroll
            for (int n = 0; n < 2; ++n) gv[bj][n] = *(const f32x4*)(gp + bj * HALF + 4 * n);
        const size_t row0 = (size_t)(u.pm * BM + wr * 64 + fr) * ldc + col0;
        f32x4 bs[2][2][2];
#pragma unroll
        for (int bj = 0; bj < 2; ++bj)
#pragma unroll
            for (int n = 0; n < 2; ++n) bs[0][bj][n] = *(const f32x4*)(base + row0 + bj * HALF + 4 * n);
#pragma unroll
        for (int g = 0; g < 8; ++g) { const int ai = g >> 2, m = g & 3; const size_t off = row0 + (size_t)(ai * HALF + m * 16) * ldc;
            if (g < 7) { const size_t offn = row0 + (size_t)(((g + 1) >> 2) * HALF + ((g + 1) & 3) * 16) * ldc;
#pragma unroll
                for (int bj = 0; bj < 2; ++bj)
#pragma unroll
                    for (int n = 0; n < 2; ++n) bs[(g + 1) & 1][bj][n] = *(const f32x4*)(base + offn + bj * HALF + 4 * n); }
#pragma unroll
            for (int bj = 0; bj < 2; ++bj) { const f32x4 v0 = bs[g & 1][bj][0] + gv[bj][0] * acc[ai][bj][m][0], v1 = bs[g & 1][bj][1] + gv[bj][1] * acc[ai][bj][m][1];
                u32x4 w; w.x = cvt_pk_bf16(v0[0], v0[1]); w.y = cvt_pk_bf16(v0[2], v0[3]); w.z = cvt_pk_bf16(v1[0], v1[1]); w.w = cvt_pk_bf16(v1[2], v1[3]);
                *(u32x4*)(out + off + bj * HALF) = w; }
        }
    }
};
struct EpiResGateFromBf16 {
    static constexpr bool PERM = true, AFTER_DRAIN = false;
    const bf16_t* base; float* out; int ldc; const float* gate; int gate_stride; int rows_per_batch;
    __device__ __forceinline__ void operator()(const f32x4 (&acc)[2][2][4][2], const Unit& u, int wr, int wc, int fr, int fq) const {
        const int col0 = u.pn * BM + wc * 32 + 8 * fq;
        const int b = (u.pm * BM) / rows_per_batch;
        const float* gp = gate + (size_t)b * gate_stride + col0;
        f32x4 gv[2][2];
#pragma unroll
        for (int bj = 0; bj < 2; ++bj)
#pragma unroll
            for (int n = 0; n < 2; ++n) gv[bj][n] = *(const f32x4*)(gp + bj * HALF + 4 * n);
        const size_t row0 = (size_t)(u.pm * BM + wr * 64 + fr) * ldc + col0;
        u32x4 bs[2][2];
#pragma unroll
        for (int bj = 0; bj < 2; ++bj) bs[0][bj] = *(const u32x4*)(base + row0 + bj * HALF);
#pragma unroll
        for (int g = 0; g < 8; ++g) { const int ai = g >> 2, m = g & 3; const size_t off = row0 + (size_t)(ai * HALF + m * 16) * ldc;
            if (g < 7) { const size_t offn = row0 + (size_t)(((g + 1) >> 2) * HALF + ((g + 1) & 3) * 16) * ldc;
#pragma unroll
                for (int bj = 0; bj < 2; ++bj) bs[(g + 1) & 1][bj] = *(const u32x4*)(base + offn + bj * HALF); }
#pragma unroll
            for (int bj = 0; bj < 2; ++bj) { const u32x4 w = bs[g & 1][bj];
                const f32x4 x0 = {__builtin_bit_cast(float, w.x << 16), __builtin_bit_cast(float, w.x & 0xffff0000u), __builtin_bit_cast(float, w.y << 16), __builtin_bit_cast(float, w.y & 0xffff0000u)};
                const f32x4 x1 = {__builtin_bit_cast(float, w.z << 16), __builtin_bit_cast(float, w.z & 0xffff0000u), __builtin_bit_cast(float, w.w << 16), __builtin_bit_cast(float, w.w & 0xffff0000u)};
                *(f32x4*)(out + off + bj * HALF) = x0 + gv[bj][0] * acc[ai][bj][m][0];
                *(f32x4*)(out + off + bj * HALF + 4) = x1 + gv[bj][1] * acc[ai][bj][m][1]; }
        }
    }
};
struct EpiBf16QK {
    static constexpr bool PERM = true, AFTER_DRAIN = false;
    bf16_t* O; int ldc; const float* qg; const float* kg; PG8_LAS float* part;
    __device__ __forceinline__ void operator()(const f32x4 (&acc)[2][2][4][2], const Unit& u, int wr, int wc, int fr, int fq) const {
        const int row0 = u.pm * BM + wr * 64 + fr, col0 = u.pn * BM + wc * 32 + 8 * fq;
        const bool normed = u.pn < 16;
        f32x4 g0 = {1.f, 1.f, 1.f, 1.f}, g1 = g0;
        if (normed) {
            const float* gp = (u.pn < 8 ? qg : kg) + wc * 32 + 8 * fq; g0 = *(const f32x4*)gp; g1 = *(const f32x4*)(gp + 4);
#pragma unroll
            for (int ai = 0; ai < 2; ++ai)
#pragma unroll
                for (int m = 0; m < 4; ++m)
#pragma unroll
                    for (int bj = 0; bj < 2; ++bj) { const f32x4 v0 = acc[ai][bj][m][0], v1 = acc[ai][bj][m][1];
                        float ss = ((v0[0] * v0[0] + v0[1] * v0[1]) + (v0[2] * v0[2] + v0[3] * v0[3])) + ((v1[0] * v1[0] + v1[1] * v1[1]) + (v1[2] * v1[2] + v1[3] * v1[3]));
                        ss += __shfl_xor(ss, 16); ss += __shfl_xor(ss, 32);
                        if (fq == 0) part[((ai * HALF + wr * 64 + m * 16 + fr) * 2 + bj) * 4 + wc] = ss; }
            asm volatile("s_waitcnt lgkmcnt(0)" ::: "memory"); __builtin_amdgcn_s_barrier(); asm volatile("" ::: "memory");
        }
#pragma unroll
        for (int ai = 0; ai < 2; ++ai)
#pragma unroll
            for (int m = 0; m < 4; ++m) { bf16_t* rowp = O + (size_t)(row0 + ai * HALF + m * 16) * ldc + col0;
#pragma unroll
                for (int bj = 0; bj < 2; ++bj) { f32x4 v0 = acc[ai][bj][m][0] + 0.f, v1 = acc[ai][bj][m][1] + 0.f;
                    if (normed) { const f32x4 p = *(const PG8_LAS f32x4*)(part + ((ai * HALF + wr * 64 + m * 16 + fr) * 2 + bj) * 4);
                        const float rstd = 1.0f / sqrtf(((p[0] + p[1]) + (p[2] + p[3])) * (1.0f / 128.0f) + 1e-6f);
                        v0 = v0 * rstd * g0; v1 = v1 * rstd * g1; }
                    u32x4 w; w.x = cvt_pk_bf16(v0[0], v0[1]); w.y = cvt_pk_bf16(v0[2], v0[3]); w.z = cvt_pk_bf16(v1[0], v1[1]); w.w = cvt_pk_bf16(v1[2], v1[3]);
                    *(u32x4*)(rowp + bj * HALF) = w; } }
    }
};
struct EpiBf16QKL {
    static constexpr bool PERM = true, AFTER_DRAIN = false, BADJ = true;
    bf16_t* O; int ldc; const float* qg; const float* kg; PG8_LAS float* part;
    __device__ __forceinline__ void operator()(const f32x4 (&acc)[2][2][4][2], const Unit& u, int wr, int wc, int fr, int fq) const {
        const bool normed = u.pn < 16, lo = fr < 8;
        f32x4 g[2][2];
#pragma unroll
        for (int bj = 0; bj < 2; ++bj)
#pragma unroll
            for (int n = 0; n < 2; ++n) g[bj][n] = (f32x4){1.f, 1.f, 1.f, 1.f};
        if (normed) {
            const float* gp = (u.pn < 8 ? qg : kg) + (wc & 1) * 64 + 8 * fq;
#pragma unroll
            for (int bj = 0; bj < 2; ++bj)
#pragma unroll
                for (int n = 0; n < 2; ++n) g[bj][n] = *(const f32x4*)(gp + bj * 32 + 4 * n);
#pragma unroll
            for (int ai = 0; ai < 2; ++ai)
#pragma unroll
                for (int m = 0; m < 4; ++m) { float ss = 0.f;
                    { const f32x4 a0 = acc[ai][0][m][0], a1 = acc[ai][0][m][1], b0 = acc[ai][1][m][0], b1 = acc[ai][1][m][1];
                      ss = (((a0[0] * a0[0] + a0[1] * a0[1]) + (a0[2] * a0[2] + a0[3] * a0[3])) + ((a1[0] * a1[0] + a1[1] * a1[1]) + (a1[2] * a1[2] + a1[3] * a1[3])))
                         + (((b0[0] * b0[0] + b0[1] * b0[1]) + (b0[2] * b0[2] + b0[3] * b0[3])) + ((b1[0] * b1[0] + b1[1] * b1[1]) + (b1[2] * b1[2] + b1[3] * b1[3]))); }
                    ss += __shfl_xor(ss, 16); ss += __shfl_xor(ss, 32);
                    if (fq == 0) part[(ai * HALF + wr * 64 + m * 16 + fr) * 4 + wc] = ss; }
            asm volatile("s_waitcnt lgkmcnt(0)" ::: "memory"); __builtin_amdgcn_s_barrier(); asm volatile("" ::: "memory");
        }
        bf16_t* base = O + (size_t)(u.pm * BM + wr * 64 + (fr & 7)) * ldc + u.pn * BM + wc * 64 + (lo ? 0 : 32) + 8 * fq;
#pragma unroll
        for (int ai = 0; ai < 2; ++ai)
#pragma unroll
            for (int m = 0; m < 4; ++m) {
                float rstd = 1.f;
                if (normed) { const PG8_LAS float* p = part + (ai * HALF + wr * 64 + m * 16 + fr) * 4 + (wc & 2); rstd = 1.0f / sqrtf((p[0] + p[1]) * (1.0f / 128.0f) + 1e-6f); }
                u32x4 w[2];
#pragma unroll
                for (int bj = 0; bj < 2; ++bj) { const f32x4 v0 = acc[ai][bj][m][0] * rstd * g[bj][0], v1 = acc[ai][bj][m][1] * rstd * g[bj][1];
                    w[bj].x = cvt_pk_bf16(v0[0], v0[1]); w[bj].y = cvt_pk_bf16(v0[2], v0[3]); w[bj].z = cvt_pk_bf16(v1[0], v1[1]); w[bj].w = cvt_pk_bf16(v1[2], v1[3]); }
                const u32x4 snd = lo ? w[1] : w[0];
                u32x4 rcv; rcv.x = __shfl_xor(snd.x, 8); rcv.y = __shfl_xor(snd.y, 8); rcv.z = __shfl_xor(snd.z, 8); rcv.w = __shfl_xor(snd.w, 8);
                bf16_t* rp = base + (size_t)(ai * HALF + m * 16) * ldc;
                *(u32x4*)rp = lo ? w[0] : rcv;
                *(u32x4*)(rp + (size_t)8 * ldc) = lo ? rcv : w[1];
                asm volatile("" ::: "memory");
            }
    }
};
struct EpiScalars {
    static constexpr bool PERM = false, AFTER_DRAIN = false;
    float* FLS; float* GG; float* GB; const float* f_bias; const float* a_log; const float* dt_bias; int seq, nh;
    __device__ __forceinline__ void operator()(const f32x4 (&acc)[2][2][4][2], const Unit& u, int wr, int wc, int fr, int fq) const {
        const bool diag = (((fr >> 2) ^ fq) & 1) == 0;
        const int e = fr & 3, ks = fr & 7;
        float mine[4] = {0.f, 0.f, 0.f, 0.f};
#pragma unroll
        for (int ai = 0; ai < 2; ++ai)
#pragma unroll
            for (int m = 0; m < 4; ++m)
#pragma unroll
                for (int bj = 0; bj < 2; ++bj)
#pragma unroll
                    for (int n = 0; n < 2; ++n) { const f32x4 a4 = acc[ai][bj][m][n];
                        float v = diag ? (e == 0 ? a4[0] : (e == 1 ? a4[1] : (e == 2 ? a4[2] : a4[3]))) : 0.f;
                        v += __shfl_xor(v, 1); v += __shfl_xor(v, 2); v += __shfl_xor(v, 20);
                        if (ks == ai * 4 + m) mine[bj * 2 + n] = v; }
        if (!diag) return;
        const int row = 32 * u.pm + 16 * (ks >> 2) + 8 * wr + 2 * (ks & 3) + (fr >> 3), b = row / seq, t = row % seq;
#pragma unroll
        for (int j = 0; j < 4; ++j) { const int col = 32 * u.pn + 16 * (j >> 1) + 4 * wc + 2 * (j & 1) + (fq >> 1);
            if (col < 48) { const int h = col & 15; const size_t o = (size_t)(b * nh + h) * seq + t; const float v = mine[j];
                if (col < 16) { const float z = v + f_bias[h]; FLS[o] = (z < 0.f ? z : 0.f) - log1pf(expf(-fabsf(z))); }
                else if (col < 32) { const float xs = v + dt_bias[h]; const float sp_ = xs > 20.f ? xs : log1pf(expf(xs)); GG[o] = -expf(a_log[h]) * sp_; }
                else GB[o] = 1.0f / (1.0f + expf(-v)); } }
    }
};
struct EpiProbe {
    static constexpr bool PERM = true, AFTER_DRAIN = false;
    float* sink;
    __device__ __forceinline__ void operator()(const f32x4 (&acc)[2][2][4][2], const Unit& u, int wr, int wc, int fr, int fq) const {
        f32x4 s = {0.f, 0.f, 0.f, 0.f};
#pragma unroll
        for (int ai = 0; ai < 2; ++ai)
#pragma unroll
            for (int bj = 0; bj < 2; ++bj)
#pragma unroll
                for (int m = 0; m < 4; ++m)
#pragma unroll
                    for (int n = 0; n < 2; ++n) s += acc[ai][bj][m][n];
        const float t = (s.x + s.y) + (s.z + s.w);
        if (t == 12345.678f) sink[u.pm * 64 + u.pn] = t;
    }
};

template <class E, class = void> struct badj_of { static constexpr bool v = false; };
template <class E> struct badj_of<E, decltype((void)E::BADJ)> { static constexpr bool v = E::BADJ; };
template <class Epi, class Sched, bool ALIGN_EPI = false, bool SP2 = false>
__device__ __forceinline__ void gemm_phase(PG8_LAS unsigned char* lds, const Gemm g, const Sched& S, const Epi& E) {
    int tid_ = threadIdx.x; asm volatile("" : "+v"(tid_));
    const int tid = tid_, wid = __builtin_amdgcn_readfirstlane(tid >> 6), lane = tid & 63, wr = wid >> 2, wc = wid & 3, fr = lane & 15, fq = lane >> 4;
    const int K = g.ld, nt = g.K / BK;
    unsigned voffA[2], voffB[2];
    constexpr bool BADJ = badj_of<Epi>::v;
#pragma unroll
    for (int i = 0; i < 2; ++i) { int R, C; stage_rc(tid * 16 + i * 8192, R, C); const int Rb = BADJ ? ((R >> 5) * 64 + perm32(R & 31)) : (Epi::PERM ? ((R & ~31) + perm32(R & 31)) : R);
        voffA[i] = (unsigned)(R * K + C) * 2u; voffB[i] = (unsigned)(Rb * K + C) * 2u; }
    const size_t kstep = (size_t)(BK * 2);
    const size_t hstep = (size_t)HALF * K * 2;
    const size_t hstepB = BADJ ? (size_t)32 * K * 2 : hstep;
    const size_t tstep = 2 * hstep;
    const unsigned ldsw = (unsigned)wid * 1024u;
    const int aoff = lds_byte(wr * 64 + fr, fq * 8), boff = lds_byte(wc * 32 + fr, fq * 8);
#define PG8_SA(b, h) (((b) * 2 + (h)) * HTB)
#define PG8_SB(b, h) ((4 + (b) * 2 + (h)) * HTB)
#define PG8_STAGE(bufoff, gbase, voff) do { _Pragma("unroll") for (int _i = 0; _i < 2; ++_i) \
        __builtin_amdgcn_global_load_lds((const unsigned*)((const char*)(gbase) + (voff)[_i]), (PG8_LAS unsigned*)(lds + (bufoff) + ldsw + _i * 8192), 16, 0, 0); } while (0)
#define PG8_LDA(dst, b, h) do { _Pragma("unroll") for (int m = 0; m < 4; ++m) _Pragma("unroll") for (int k = 0; k < 2; ++k) dst[m][k] = *(const PG8_LAS bf16x8*)(lds + PG8_SA(b, h) + aoff + m * 2048 + k * 1024); } while (0)
#define PG8_LDB(dst, b, h) do { _Pragma("unroll") for (int n = 0; n < 2; ++n) _Pragma("unroll") for (int k = 0; k < 2; ++k) dst[n][k] = *(const PG8_LAS bf16x8*)(lds + PG8_SB(b, h) + boff + n * 2048 + k * 1024); } while (0)
#define PG8_MMA(ai, bj, At, Bt) do { __builtin_amdgcn_s_setprio(1); _Pragma("unroll") for (int m = 0; m < 4; ++m) _Pragma("unroll") for (int n = 0; n < 2; ++n) _Pragma("unroll") for (int k = 0; k < 2; ++k) \
        acc[ai][bj][m][n] = __builtin_amdgcn_mfma_f32_16x16x32_bf16(Bt[n][k], At[m][k], acc[ai][bj][m][n], 0, 0, 0); __builtin_amdgcn_s_setprio(0); } while (0)
#define PG8_WAIT_V(n) asm volatile("s_waitcnt vmcnt(" #n ")" ::: "memory")
#define PG8_WAIT_L(n) asm volatile("s_waitcnt lgkmcnt(" #n ")" ::: "memory")
#define PG8_BAR __builtin_amdgcn_s_barrier()
#define PG8_SCHED __builtin_amdgcn_sched_barrier(0)
    Unit cur, nxt; int ui = 0;
    if (!S.next(0, cur)) return;
    f32x4 acc[2][2][4][2];
#pragma unroll
    for (int a = 0; a < 2; ++a)
#pragma unroll
        for (int b = 0; b < 2; ++b)
#pragma unroll
            for (int m = 0; m < 4; ++m)
#pragma unroll
                for (int n = 0; n < 2; ++n) acc[a][b][m][n] = (f32x4){0.f, 0.f, 0.f, 0.f};
    bf16x8 At[4][2], B0[2][2], B1[2][2];
    const char* cA = (const char*)g.A + (size_t)cur.pm * tstep; const char* cB = (const char*)g.Bt + (size_t)cur.pn * tstep;
    S.a_ready(cur);
    if constexpr (SP2) {
        PG8_STAGE(PG8_SB(0, 0), cB, voffB); PG8_STAGE(PG8_SB(0, 1), cB + hstepB, voffB); PG8_STAGE(PG8_SA(0, 0), cA, voffA); PG8_STAGE(PG8_SA(0, 1), cA + hstep, voffA);
        if (wr == 1) PG8_BAR;
        PG8_WAIT_V(2); PG8_BAR;
        PG8_STAGE(PG8_SB(1, 0), cB + kstep, voffB); PG8_STAGE(PG8_SA(1, 0), cA + kstep, voffA); PG8_STAGE(PG8_SB(1, 1), cB + hstepB + kstep, voffB);
        PG8_WAIT_V(6); PG8_BAR;
    } else {
        PG8_STAGE(PG8_SB(0, 0), cB, voffB); PG8_STAGE(PG8_SA(0, 0), cA, voffA); PG8_STAGE(PG8_SB(0, 1), cB + hstepB, voffB); PG8_STAGE(PG8_SA(0, 1), cA + hstep, voffA);
        if (wr == 1) PG8_BAR;
        PG8_WAIT_V(4); PG8_BAR;
        PG8_STAGE(PG8_SB(1, 0), cB + kstep, voffB); PG8_STAGE(PG8_SA(1, 0), cA + kstep, voffA); PG8_STAGE(PG8_SB(1, 1), cB + hstepB + kstep, voffB);
        PG8_WAIT_V(6); PG8_BAR;
    }
    for (;;) {
        const bool has_next = S.next(ui + 1, nxt);
        const char* nA = has_next ? (const char*)g.A + (size_t)nxt.pm * tstep : cA; const char* nB = has_next ? (const char*)g.Bt + (size_t)nxt.pn * tstep : cB;
        for (int t = 0; t < nt; t += 2) {
            const bool last = (t == nt - 2);
            const char* a1 = cA + (size_t)(t + 1) * kstep;
            const char* a2 = last ? nA : cA + (size_t)(t + 2) * kstep; const char* b2 = last ? nB : cB + (size_t)(t + 2) * kstep;
            const char* a3 = a2 + kstep; const char* b3 = b2 + kstep;
            if (last && has_next) S.a_ready(nxt);
            if constexpr (SP2) {
            PG8_LDB(B0, 0, 0); PG8_LDB(B1, 0, 1); PG8_SCHED; PG8_LDA(At, 0, 0); PG8_STAGE(PG8_SA(1, 1), a1 + hstep, voffA);
            PG8_WAIT_V(8); PG8_WAIT_L(0); PG8_BAR; PG8_MMA(0, 0, At, B0); PG8_MMA(0, 1, At, B1); PG8_BAR; PG8_SCHED;
            PG8_LDA(At, 0, 1); PG8_STAGE(PG8_SB(0, 0), b2, voffB); PG8_STAGE(PG8_SB(0, 1), b2 + hstepB, voffB); PG8_STAGE(PG8_SA(0, 0), a2, voffA);
            PG8_WAIT_V(8); PG8_WAIT_L(0); PG8_BAR; PG8_MMA(1, 0, At, B0); PG8_MMA(1, 1, At, B1); PG8_BAR; PG8_SCHED;
            PG8_LDB(B0, 1, 0); PG8_LDB(B1, 1, 1); PG8_SCHED; PG8_LDA(At, 1, 0); PG8_STAGE(PG8_SA(0, 1), a2 + hstep, voffA);
            PG8_WAIT_V(8); PG8_WAIT_L(0); PG8_BAR; PG8_MMA(0, 0, At, B0); PG8_MMA(0, 1, At, B1); PG8_BAR; PG8_SCHED;
            PG8_LDA(At, 1, 1); PG8_STAGE(PG8_SB(1, 0), b3, voffB); PG8_STAGE(PG8_SB(1, 1), b3 + hstepB, voffB); PG8_STAGE(PG8_SA(1, 0), a3, voffA);
            PG8_WAIT_V(8); PG8_WAIT_L(0); PG8_BAR; PG8_MMA(1, 0, At, B0); PG8_MMA(1, 1, At, B1); PG8_BAR; PG8_SCHED;
            } else {
            PG8_LDB(B0, 0, 0); PG8_SCHED; PG8_LDA(At, 0, 0); PG8_STAGE(PG8_SA(1, 1), a1 + hstep, voffA);
            PG8_WAIT_L(8); PG8_BAR; PG8_WAIT_L(0); PG8_MMA(0, 0, At, B0); PG8_BAR; PG8_SCHED;
            PG8_LDB(B1, 0, 1); PG8_STAGE(PG8_SB(0, 0), b2, voffB);
            PG8_BAR; PG8_WAIT_L(0); PG8_MMA(0, 1, At, B1); PG8_BAR;
            PG8_LDA(At, 0, 1); PG8_STAGE(PG8_SA(0, 0), a2, voffA);
            PG8_BAR; PG8_WAIT_L(0); PG8_MMA(1, 0, At, B0); PG8_BAR; PG8_SCHED;
            PG8_STAGE(PG8_SB(0, 1), b2 + hstepB, voffB);
            PG8_WAIT_V(6); PG8_BAR; PG8_MMA(1, 1, At, B1); PG8_BAR;
            PG8_LDB(B0, 1, 0); PG8_SCHED; PG8_LDA(At, 1, 0); PG8_STAGE(PG8_SA(0, 1), a2 + hstep, voffA);
            PG8_WAIT_L(8); PG8_BAR; PG8_WAIT_L(0); PG8_MMA(0, 0, At, B0); PG8_BAR; PG8_SCHED;
            PG8_LDB(B1, 1, 1); PG8_STAGE(PG8_SB(1, 0), b3, voffB);
            PG8_BAR; PG8_WAIT_L(0); PG8_MMA(0, 1, At, B1); PG8_BAR;
            PG8_LDA(At, 1, 1); PG8_STAGE(PG8_SA(1, 0), a3, voffA);
            PG8_BAR; PG8_WAIT_L(0); PG8_MMA(1, 0, At, B0); PG8_BAR; PG8_SCHED;
            PG8_STAGE(PG8_SB(1, 1), b3 + hstepB, voffB);
            PG8_WAIT_V(6); PG8_BAR; PG8_MMA(1, 1, At, B1); PG8_BAR;
            }
        }
        if constexpr (ALIGN_EPI) { if (wr == 0) PG8_BAR; }
        if constexpr (!Epi::AFTER_DRAIN) { E(acc, cur, wr, wc, fr, fq); S.done(cur); }
        if (!has_next) break;
#pragma unroll
        for (int a = 0; a < 2; ++a)
#pragma unroll
            for (int b = 0; b < 2; ++b)
#pragma unroll
                for (int m = 0; m < 4; ++m)
#pragma unroll
                    for (int n = 0; n < 2; ++n) acc[a][b][m][n] = (f32x4){0.f, 0.f, 0.f, 0.f};
        cur = nxt; cA = nA; cB = nB; ++ui;
        if constexpr (ALIGN_EPI) { if (wr == 1) PG8_BAR; }
    }
    PG8_WAIT_V(0);
    if constexpr (!ALIGN_EPI) { if (wr == 0) PG8_BAR; }
    PG8_BAR;
    if constexpr (Epi::AFTER_DRAIN) { E.fused(acc, cur, wr, wc, fr, fq, lds, wid, lane); S.done(cur); }
#undef PG8_SA
#undef PG8_SB
#undef PG8_STAGE
#undef PG8_LDA
#undef PG8_LDB
#undef PG8_MMA
#undef PG8_WAIT_V
#undef PG8_WAIT_L
#undef PG8_BAR
#undef PG8_SCHED
}
}
namespace fox {
typedef unsigned short bf16;
typedef short bf16x8 __attribute__((ext_vector_type(8)));
typedef short s16x4 __attribute__((ext_vector_type(4)));
typedef float f32x16 __attribute__((ext_vector_type(16)));
typedef float f32x4 __attribute__((ext_vector_type(4)));
typedef unsigned u32x4 __attribute__((ext_vector_type(4)));
constexpr int D = 128, NW = 8, QBLK = 32, KVBLK = 64, QB = NW * QBLK;
constexpr int SHM_V = KVBLK * D * 2, SHM_K = KVBLK * D * 2;
constexpr int LDS_WS = 2 * SHM_V + 2 * SHM_K, LDS_KX = LDS_WS + NW * 64 * 4, LDS_Q = LDS_KX + 2 * 1024, LDS_BYTES = LDS_Q + NW * QBLK * D * 2;
constexpr float SCALE = 0.08838834764831845f;
constexpr float C2 = 1.4426950408889634f * SCALE;
constexpr float THR = 8.f;

#define KSWZ(row, colB) ((row) * 256 + ((colB) ^ (((row) & 7) << 4)))
#define SBAR() __builtin_amdgcn_sched_barrier(0)
__device__ __forceinline__ int v_st(int k, int c) { const int kk = (k & ~0xC) | ((k & 4) << 1) | ((k & 8) >> 1); return ((kk >> 3) * 4 + (c >> 5)) * 512 + ((kk & 7) * 32 + (c & 31)) * 2; }
__device__ __forceinline__ int v_rd_base(int lane) { return ((lane & 3) << 3) | (((lane >> 2) & 3) << 6) | (((lane >> 4) & 1) << 5) | (((lane >> 5) & 1) << 8); }
constexpr int v_rd_off(int d0, int ks, int half) { return d0 * 512 + ks * 4096 + half * 2048; }
__device__ __forceinline__ int crow(int r, int hi) { return (r & 3) + 8 * (r >> 2) + 4 * hi; }
__device__ __forceinline__ unsigned cvtpk(float lo, float hi) { unsigned r; asm volatile("v_cvt_pk_bf16_f32 %0, %1, %2" : "=v"(r) : "v"(lo), "v"(hi)); return r; }
__device__ __forceinline__ bf16x8 load8(const bf16* p) { return *reinterpret_cast<const bf16x8*>(p); }
__device__ __forceinline__ void mask_tile(f32x16& p0, f32x16& p1, int dq) {
    const float NEG = -__builtin_inff();
#pragma unroll
    for (int r = 0; r < 16; ++r) {
        const int c = (r & 3) + 8 * (r >> 2);
        if (dq - c < 0) p0[r] = NEG;
        if (dq - c - 32 < 0) p1[r] = NEG;
    }
}
__device__ __forceinline__ void partialSM(f32x16& p0, f32x16& p1, float& m_reg, float& mn, float& alpha) {
    float pmax = p0[0];
#pragma unroll
    for (int r = 1; r < 16; ++r) pmax = fmaxf(pmax, p0[r]);
#pragma unroll
    for (int r = 0; r < 16; ++r) pmax = fmaxf(pmax, p1[r]);
    { auto rr = __builtin_amdgcn_permlane32_swap(__float_as_uint(pmax), __float_as_uint(pmax), false, false);
      pmax = fmaxf(__uint_as_float(rr[0]), __uint_as_float(rr[1])); }
    if (__builtin_expect(__all((pmax - m_reg) * SCALE <= THR), 1)) { mn = m_reg; alpha = 1.f; }
    else { mn = fmaxf(m_reg, pmax); alpha = __builtin_amdgcn_exp2f((m_reg - mn) * C2); m_reg = mn; }
    const float mnL = -mn * C2;
#pragma unroll
    for (int r = 0; r < 16; ++r) p0[r] = fmaf(p0[r], C2, mnL);
#pragma unroll
    for (int r = 0; r < 16; ++r) p1[r] = fmaf(p1[r], C2, mnL);
#pragma unroll
    for (int r = 0; r < 16; ++r) p0[r] = __builtin_amdgcn_exp2f(p0[r]);
}
__device__ __forceinline__ void finishSM(f32x16& p0, f32x16& p1, float alpha, float& l_reg, bf16x8& pa0, bf16x8& pa1, bf16x8& pa2, bf16x8& pa3) {
#pragma unroll
    for (int r = 0; r < 16; ++r) p1[r] = __builtin_amdgcn_exp2f(p1[r]);
    float ps = 0;
#pragma unroll
    for (int r = 0; r < 16; ++r) ps += p0[r];
#pragma unroll
    for (int r = 0; r < 16; ++r) ps += p1[r];
    { auto rr = __builtin_amdgcn_permlane32_swap(__float_as_uint(ps), __float_as_uint(ps), false, false);
      ps = __uint_as_float(rr[0]) + __uint_as_float(rr[1]); }
    l_reg = l_reg * alpha + ps;
#define PK4(P, B_, OUT) do { unsigned a0 = cvtpk(P[B_+0], P[B_+1]), a1 = cvtpk(P[B_+2], P[B_+3]);                          \
        unsigned b0 = cvtpk(P[B_+4], P[B_+5]), b1 = cvtpk(P[B_+6], P[B_+7]);                                             \
        auto r0 = __builtin_amdgcn_permlane32_swap(a0, b0, false, false); auto r1 = __builtin_amdgcn_permlane32_swap(a1, b1, false, false); \
        u32x4 w = {r0[0], r1[0], r0[1], r1[1]}; OUT = *reinterpret_cast<bf16x8*>(&w); } while (0)
    PK4(p0, 0, pa0); PK4(p0, 8, pa1); PK4(p1, 0, pa2); PK4(p1, 8, pa3);
#undef PK4
}
template <int KB>
__device__ __forceinline__ void qkt(f32x16& p0, f32x16& p1, const char* K_lds, const char* KX_lds, int r32, int hi, const char* Qw) {
    p0 = f32x16{}; p1 = f32x16{};
    {
        const short one = hi ? (short)0 : (short)0x3F80;
        const bf16x8 qx = {one, one, one, 0, 0, 0, 0, 0};
        const bf16x8 x0 = *reinterpret_cast<const bf16x8*>(KX_lds + KB * 1024 + r32 * 16);
        const bf16x8 x1 = *reinterpret_cast<const bf16x8*>(KX_lds + KB * 1024 + (32 + r32) * 16);
        p0 = __builtin_amdgcn_mfma_f32_32x32x16_bf16(x0, qx, p0, 0, 0, 0);
        p1 = __builtin_amdgcn_mfma_f32_32x32x16_bf16(x1, qx, p1, 0, 0, 0); }
    const char* kb[4]; const char* qb[4];
#pragma unroll
    for (int dd = 0; dd < 4; ++dd) { const int sw = KSWZ(r32, (dd * 16 + hi * 8) * 2); kb[dd] = K_lds + KB * SHM_K + sw; qb[dd] = Qw + sw; }
#pragma unroll
    for (int d0 = 0; d0 < 8; ++d0) { const char* a = kb[d0 & 3] + (d0 >> 2) * 128;
        bf16x8 b0 = *reinterpret_cast<const bf16x8*>(a);
        bf16x8 b1 = *reinterpret_cast<const bf16x8*>(a + 32 * 256);
        bf16x8 q = *reinterpret_cast<const bf16x8*>(qb[d0 & 3] + (d0 >> 2) * 128);
        p0 = __builtin_amdgcn_mfma_f32_32x32x16_bf16(b0, q, p0, 0, 0, 0);
        p1 = __builtin_amdgcn_mfma_f32_32x32x16_bf16(b1, q, p1, 0, 0, 0); }
}
template <int VB>
__device__ __forceinline__ void pv_tile(f32x16* o, int vb0, bf16x8 pa0, bf16x8 pa1, bf16x8 pa2, bf16x8 pa3) {
#define TRRD(dst, off) asm volatile("ds_read_b64_tr_b16 %0, %1 offset:%2" : "=&v"(dst) : "v"(vb0), "i"(off) : "memory")
#define PV_D0(d0) do { s16x4 l0, l1, l2, l3, h0, h1, h2, h3; constexpr int b_ = VB * SHM_V + v_rd_off(d0, 0, 0); \
        TRRD(l0, b_); TRRD(h0, b_ + 2048); TRRD(l1, b_ + 4096); TRRD(h1, b_ + 6144); TRRD(l2, b_ + 8192); TRRD(h2, b_ + 10240); TRRD(l3, b_ + 12288); TRRD(h3, b_ + 14336); \
        asm volatile("s_waitcnt lgkmcnt(0)" ::: "memory"); SBAR();   \
        o[d0] = __builtin_amdgcn_mfma_f32_32x32x16_bf16(pa0, (bf16x8){l0[0], l0[1], l0[2], l0[3], h0[0], h0[1], h0[2], h0[3]}, o[d0], 0, 0, 0);   \
        o[d0] = __builtin_amdgcn_mfma_f32_32x32x16_bf16(pa1, (bf16x8){l1[0], l1[1], l1[2], l1[3], h1[0], h1[1], h1[2], h1[3]}, o[d0], 0, 0, 0);   \
        o[d0] = __builtin_amdgcn_mfma_f32_32x32x16_bf16(pa2, (bf16x8){l2[0], l2[1], l2[2], l2[3], h2[0], h2[1], h2[2], h2[3]}, o[d0], 0, 0, 0);   \
        o[d0] = __builtin_amdgcn_mfma_f32_32x32x16_bf16(pa3, (bf16x8){l3[0], l3[1], l3[2], l3[3], h3[0], h3[1], h3[2], h3[3]}, o[d0], 0, 0, 0); } while (0)
    PV_D0(0); PV_D0(1); PV_D0(2); PV_D0(3);
#undef PV_D0
#undef TRRD
}

struct BlockRef { unsigned q, k, v, kx, o; int P0; };
struct Bases { const bf16* P; const bf16* KX; bf16* O; };
struct Seam { bf16x8 st_v0, st_v1, st_k0, st_k1; };
#define ROW(p, k0, rr) ((p) + (size_t)(k0) * PQ + (unsigned)((rr) * PQ + sc))
#define VMW() asm volatile("s_waitcnt vmcnt(0)" ::: "memory")
#define VMWN(n) asm volatile("s_waitcnt vmcnt(%0)" :: "i"(n) : "memory")
#define SLOAD_H(Kp, Vp, KXp, k0, kxb) do { S.st_v0 = load8(ROW(Vp, k0, sr)); S.st_v1 = load8(ROW(Vp, k0, 32 + sr));              \
                         S.st_k0 = load8(ROW(Kp, k0, sr)); S.st_k1 = load8(ROW(Kp, k0, 32 + sr));                                 \
                         if (wid == 0) __builtin_amdgcn_global_load_lds((const unsigned*)((KXp) + (size_t)(k0) * 8 + (unsigned)(lane * 8)), (__attribute__((address_space(3))) unsigned*)(KX_lds + (kxb) * 1024), 16, 0, 0); } while (0)
#define SWRITE_HK(bf) do { *(bf16x8*)(K_lds + (bf) * SHM_K + kws) = S.st_k0; *(bf16x8*)(K_lds + (bf) * SHM_K + kws + 32 * 256) = S.st_k1; } while (0)
#define SWRITE_HV(bf) do { *(bf16x8*)(V_lds + (bf) * SHM_V + vst0) = S.st_v0; *(bf16x8*)(V_lds + (bf) * SHM_V + vst1) = S.st_v1; } while (0)
#define SWRITE_H(bf) do { SWRITE_HV(bf); SWRITE_HK(bf); } while (0)
#define QLOAD(qoff) do { _Pragma("unroll") for (int i_ = 0; i_ < 8; ++i_) { const int row_ = 4 * i_ + (lane >> 4);                                             \
        __builtin_amdgcn_global_load_lds((const unsigned*)(Bs.P + (qoff) + (size_t)(wid * QBLK + 4 * i_) * PQ + (unsigned)((lane >> 4) * PQ + (((lane & 15) ^ (row_ & 7)) * 8))), \
                                         (__attribute__((address_space(3))) unsigned*)(Qw + i_ * 1024), 16, 0, 0); } } while (0)
template <int PQ, int PO>
__device__ __forceinline__ void fox_prime(const Bases& Bs, const BlockRef& cur, char* lds, Seam& S) {
    const int tid = threadIdx.x, wid = __builtin_amdgcn_readfirstlane(tid >> 6), lane = tid & 63, r32 = lane & 31, hi = lane >> 5;
    const int sr = tid >> 4, sc = (tid & 15) * 8, kws = KSWZ(sr, sc * 2); char* K_lds = lds + 2 * SHM_V; char* KX_lds = lds + LDS_KX; char* Qw = lds + LDS_Q + wid * (QBLK * D * 2);
    QLOAD(cur.q);
    SLOAD_H(Bs.P + cur.k, Bs.P + cur.v, Bs.KX + (size_t)cur.kx * 8, 0, 0); VMW(); SWRITE_HK(0);
    __syncthreads();
}
template <int PQ, int PO>
__device__ __forceinline__ void fox_block(const Bases& Bs, const BlockRef& cur, const BlockRef& nxt, char* lds, Seam& S) {
    const int tid = threadIdx.x, wid = __builtin_amdgcn_readfirstlane(tid >> 6), lane = tid & 63, r32 = lane & 31, hi = lane >> 5;
    const int NT = (cur.P0 + QB - 1) / KVBLK + 1;
    const int qlo = cur.P0 + wid * QBLK, qm = qlo + r32 - 4 * hi;
    char* V_lds = lds; char* K_lds = lds + 2 * SHM_V;
    float* ws = (float*)(lds + LDS_WS) + wid * 64; float* li_l = ws, * al_l = ws + 32; char* KX_lds = lds + LDS_KX; char* Qw = lds + LDS_Q + wid * (QBLK * D * 2);
    float m_reg = -1e30f, l_reg = 0; f32x16 o[4] = {};
    const int sr = tid >> 4, sc = (tid & 15) * 8, vst0 = v_st(sr, sc), vst1 = v_st(32 + sr, sc), kws = KSWZ(sr, sc * 2);
    const int vb0 = (int)(uintptr_t)V_lds + v_rd_base(lane);
    const bf16* Kh = Bs.P + cur.k; const bf16* Vh = Bs.P + cur.v; const bf16* KXh = Bs.KX + (size_t)cur.kx * 8;
#define RESC(a) do { if (__any((a) < 1.f)) { if (hi == 0) al_l[r32] = (a); asm volatile("s_waitcnt lgkmcnt(0)" ::: "memory");              \
                     for (int d_ = 0; d_ < 4; ++d_) for (int r = 0; r < 16; ++r) o[d_][r] *= al_l[crow(r, hi)]; } } while (0)
#define KBASE(t) ((t) * KVBLK)
#define MASKT(P0_, P1_, t) do { const int kb_ = KBASE(t); if (kb_ + KVBLK - 1 > qlo) mask_tile(P0_, P1_, qm - kb_); } while (0)
    constexpr int NQL = 8;
#define SEAM_K0() do { VMWN(NQL); SWRITE_HK(0); SBAR(); } while (0)
    f32x16 pA0, pA1, pB0, pB1; float mnA, mnB, alA, alB; bf16x8 pa0, pa1, pa2, pa3;
    SWRITE_HV(0); SBAR();
    if (NT > 1) SLOAD_H(Kh, Vh, KXh, KBASE(1), 1);
    SBAR(); qkt<0>(pA0, pA1, K_lds, KX_lds, r32, hi, Qw);
    MASKT(pA0, pA1, 0); partialSM(pA0, pA1, m_reg, mnA, alA);
    if (NT > 1) { VMW(); SWRITE_H(1); }
    __syncthreads();
#define HALF_STEP(PX0, PX1, mnX, alX, PY0, PY1, alY, t, KB, VB, SB) do {                                                      \
        SBAR(); qkt<KB>(PX0, PX1, K_lds, KX_lds, r32, hi, Qw);                                                                    \
        finishSM(PY0, PY1, alY, l_reg, pa0, pa1, pa2, pa3); SBAR();                                                           \
        if ((t) + 1 < NT) { SLOAD_H(Kh, Vh, KXh, KBASE((t) + 1), SB); SBAR(); }                                                 \
        pv_tile<VB>(o, vb0, pa0, pa1, pa2, pa3); MASKT(PX0, PX1, (t)); partialSM(PX0, PX1, m_reg, mnX, alX); \
        __syncthreads();                                                                                                      \
        if ((t) + 1 < NT) { VMW(); SWRITE_H(SB); }                                                                            \
        RESC(alX); __syncthreads(); } while (0)
    for (int t = 1; t + 1 < NT; t += 2) {
        HALF_STEP(pB0, pB1, mnB, alB, pA0, pA1, alA, t, 1, 0, 0);
        HALF_STEP(pA0, pA1, mnA, alA, pB0, pB1, alB, t + 1, 0, 1, 1);
    }
    const bool even = (NT & 1) == 0;
    if (even) { SBAR(); qkt<1>(pB0, pB1, K_lds, KX_lds, r32, hi, Qw); SBAR(); }
    SLOAD_H(Bs.P + nxt.k, Bs.P + nxt.v, Bs.KX + (size_t)nxt.kx * 8, 0, 0); SBAR();
    QLOAD(nxt.q);
    SBAR();
    finishSM(pA0, pA1, alA, l_reg, pa0, pa1, pa2, pa3); SBAR();
    pv_tile<0>(o, vb0, pa0, pa1, pa2, pa3);
    if (even) { MASKT(pB0, pB1, NT - 1); partialSM(pB0, pB1, m_reg, mnB, alB); __syncthreads(); RESC(alB);
        finishSM(pB0, pB1, alB, l_reg, pa0, pa1, pa2, pa3); SBAR(); pv_tile<1>(o, vb0, pa0, pa1, pa2, pa3); }
    SBAR(); SEAM_K0();
    if (hi == 0) li_l[r32] = l_reg; asm volatile("s_waitcnt lgkmcnt(0)" ::: "memory");
    float rli[16];
#pragma unroll
    for (int r = 0; r < 16; ++r) rli[r] = __builtin_amdgcn_rcpf(li_l[crow(r, hi)]);
    bf16* Ow = Bs.O + cur.o + (size_t)(wid * QBLK) * PO;
#pragma unroll
    for (int r = 0; r < 16; ++r) { const int orow = crow(r, hi);
#pragma unroll
        for (int d0 = 0; d0 < 4; ++d0) { const float v = o[d0][r] * rli[r];
            const float vn = __shfl_xor(v, 1);
            if ((r32 & 1) == 0) *(unsigned*)(Ow + (unsigned)(orow * PO + d0 * 32 + r32)) = cvtpk(v, vn); } }
    __syncthreads();
#undef RESC
#undef KBASE
#undef MASKT
#undef SEAM_K0
#undef HALF_STEP
}
#undef ROW
#undef VMW
#undef VMWN
#undef SLOAD_H
#undef SWRITE_HK
#undef SWRITE_HV
#undef SWRITE_H
#undef SBAR
#undef KSWZ
}
#ifndef PG8_SP2
#define PG8_SP2 true
#endif
#ifndef PG8_ALIGN
#define PG8_ALIGN true
#endif
constexpr int NWAVES = 8;
#ifndef MK_ONE_LAUNCH
#define MK_ONE_LAUNCH 1
#endif
constexpr int N_PHASES = 12;

constexpr int BATCH = 2, SEQ = 4096, DM = 4096, M = BATCH * SEQ;
constexpr int HD = 128, NH = 16;
constexpr int FOXW = 2048, GDNW = 2048, FF = 11008, NMOD = 6 * DM;
constexpr int IN_COLS = 14384;
constexpr int NP = 14336;
constexpr int NPP = 14400;
constexpr int NPT = 14400;
constexpr float EPS = 1e-6f;
constexpr int PC_Q = 0, PC_K = 2048, PC_V = 4096, PC_G = 6144, PC_Z = 12288, PC_F = 14336, PC_A = 14352, PC_B = 14368;
constexpr int SRC_F = 6144, SRC_G = 6160, SRC_A = 12304, SRC_B = 12320, SRC_Z = 12336;
constexpr int ADA_KS = 64, ADA_NT = ADA_KS * (NMOD / 256);

constexpr size_t MiB = 1u << 20;
constexpr size_t WS_CTL = 0, CTL_ZERO_BYTES = 65536;
constexpr size_t WS_MOD   = 1 * MiB;
constexpr size_t WS_KX    = 5 * MiB;
constexpr size_t WS_FLS   = 2 * MiB;
constexpr size_t WS_GG    = 3 * MiB;
constexpr size_t WS_GB    = 4 * MiB;
constexpr size_t WS_MODP  = 8 * MiB;
constexpr int LDK = 4224;
constexpr int LDMIX = DM, LDWOUT = DM;
constexpr int LDH = DM, LDWIN = DM;
constexpr int LDH2 = LDK, LDWGU = LDK;
constexpr size_t WS_WIN   = 32 * MiB;
constexpr size_t WS_WOUT  = 152 * MiB;
constexpr size_t WS_WGU   = 188 * MiB;
constexpr size_t WS_WD    = 368 * MiB;
constexpr size_t WS_H     = 456 * MiB;
constexpr size_t WS_MIX   = 524 * MiB;
constexpr size_t WS_P     = 592 * MiB;
constexpr size_t WS_HID   = 592 * MiB;
constexpr size_t WS_GO    = 820 * MiB;
constexpr size_t WS_SP    = WS_GO;
constexpr size_t WS_CH    = 884 * MiB;
constexpr size_t WS_X1    = WS_CH;
constexpr size_t WS_UC    = 1004 * MiB;
constexpr size_t WS_GT    = 7 * MiB;
constexpr size_t WS_END   = 1068 * MiB;
static_assert(WS_WIN + (size_t)NPT * LDWIN * 2 <= WS_WOUT && WS_WOUT + (size_t)DM * LDWOUT * 2 <= WS_WGU && WS_WGU + (size_t)2 * FF * LDWGU * 2 <= WS_WD && WS_WD + (size_t)DM * FF * 2 <= WS_H &&
              WS_H + (size_t)M * LDH2 * 2 <= WS_MIX && LDH2 >= LDH && WS_MIX + (size_t)M * LDMIX * 2 <= WS_P && WS_P + (size_t)M * NPP * 2 <= WS_GO, "d_ws map");
constexpr int CH_W = 0, CH_Q = 16896, CH_KT = 33792, CH_AQ = 51200, CH_BYTES = 61440;
constexpr int RS_W = 264, RS_K = 136;
constexpr int NCHUNK = BATCH * NH * (SEQ / 64);
constexpr int CW_BAR = 4096, CW_QUEUE = 8192;

constexpr int RING_OFF = 0, RING_BYTES = 131072;
constexpr int PHASE_LDS = 143360;
constexpr int LDSCTL_OFF = PHASE_LDS, MISC_OFF = LDSCTL_OFF + 320;
constexpr int LDS_BYTES = 147456;
static_assert(MISC_OFF + 128 <= LDS_BYTES && fox::LDS_BYTES <= PHASE_LDS, "LDS map");

#define GAS __attribute__((address_space(1)))
#define LAS __attribute__((address_space(3)))
typedef unsigned short bf16;
typedef unsigned v4u __attribute__((ext_vector_type(4)));
typedef unsigned v2u __attribute__((ext_vector_type(2)));
typedef float f32x4 __attribute__((ext_vector_type(4)));
typedef GAS unsigned gu32;
#define RLX_AGENT __ATOMIC_RELAXED, __HIP_MEMORY_SCOPE_AGENT
#define LDS_WAIT() asm volatile("s_waitcnt lgkmcnt(0)" ::: "memory")
#define VM_WAIT() asm volatile("s_waitcnt vmcnt(0)" ::: "memory")
__device__ __forceinline__ unsigned f2bf(float f) { unsigned u = __builtin_bit_cast(unsigned, f); return (u + 0x7fffu + ((u >> 16) & 1u)) >> 16; }
typedef float pkf32x2 __attribute__((ext_vector_type(2))); typedef __bf16 pkbf16x2 __attribute__((ext_vector_type(2)));
__device__ __forceinline__ unsigned pk2(float lo, float hi) { pkf32x2 v = {lo, hi}; pkbf16x2 b = __builtin_convertvector(v, pkbf16x2); return __builtin_bit_cast(unsigned, b); }
__device__ __forceinline__ float bf2f(unsigned short h) { return __builtin_bit_cast(float, (unsigned)h << 16); }
__device__ __forceinline__ float bflo(unsigned w) { return __builtin_bit_cast(float, w << 16); }
__device__ __forceinline__ float bfhi(unsigned w) { return __builtin_bit_cast(float, w & 0xffff0000u); }
__device__ __forceinline__ float sigmoidf_(float x) { return 1.0f / (1.0f + __expf(-x)); }
__device__ __forceinline__ float siluf_(float x) { return x * __builtin_amdgcn_rcpf(1.0f + __builtin_amdgcn_exp2f(-1.4426950408889634f * x)); }

#define XB_TMO      128
#define XB_XCNT(j)  (256  + 64 * (j))
#define XB_XSUB(j)  (1280 + 64 * (j))
#define XB_XGEN(j)  (2304 + 64 * (j))
#define XB_TOP      3328
#define XB_TOPGEN   3392
#define XCD_BAR_WORDS 3456
#define XB_SPIN_CAP (1u << 18)

__device__ __forceinline__ unsigned xb_ld(unsigned* p)              { return __hip_atomic_load(p, __ATOMIC_RELAXED, __HIP_MEMORY_SCOPE_AGENT); }
__device__ __forceinline__ unsigned xb_add(unsigned* p, unsigned v) { return __hip_atomic_fetch_add(p, v, __ATOMIC_RELAXED, __HIP_MEMORY_SCOPE_AGENT); }
__device__ __forceinline__ unsigned xb_xcc_id() { return (unsigned)__builtin_amdgcn_s_getreg((3 << 11) | 20) & 0xFu; }
#define XB_SPIN(cond, bar) do { unsigned _sp = 0; while (cond) { __builtin_amdgcn_s_sleep(1); \
    if ((++_sp & 255u) == 0u) { if (xb_ld(&(bar)[XB_TMO])) break; if (_sp > XB_SPIN_CAP) { atomicAdd(&(bar)[XB_TMO], 1u); break; } } } } while (0)

struct XcdBarrier {
    unsigned* bar; unsigned x;
    volatile LAS unsigned* st;
};

__device__ __forceinline__ XcdBarrier xcd_barrier_post(unsigned* bar, volatile LAS unsigned* st) {
    XcdBarrier b; b.bar = bar; b.x = xb_xcc_id(); b.st = st;
    if (threadIdx.x == 0) (void)xb_add(&bar[XB_XCNT(b.x)], 1u);
    return b;
}
__device__ __forceinline__ void xcd_barrier_complete(unsigned* bar, unsigned x, unsigned& nloc, unsigned& nx) {
    const unsigned G = gridDim.x * gridDim.y * gridDim.z;
    unsigned sum, cnt, mine, sp = 0u;
    for (;;) {
        sum = 0u; cnt = 0u; mine = 0u;
#pragma unroll
        for (unsigned j = 0; j < 16; ++j) { const unsigned c = xb_ld(&bar[XB_XCNT(j)]); sum += c; cnt += (c > 0u) ? 1u : 0u; mine = (j == x) ? c : mine; }
        if (sum == G) break;
        __builtin_amdgcn_s_sleep(1);
        if ((++sp & 255u) == 0u) { if (xb_ld(&bar[XB_TMO])) break; if (sp > XB_SPIN_CAP) { atomicAdd(&bar[XB_TMO], 1u); break; } }
    }
    nloc = mine > 0u ? mine : 1u; nx = cnt > 0u ? cnt : 1u;
}

__device__ __forceinline__ void xcd_barrier(const XcdBarrier& b) {
    asm volatile("s_waitcnt vmcnt(0)" ::: "memory");
    __syncthreads();
    if (threadIdx.x == 0) {
        unsigned* bar = b.bar;
        __builtin_amdgcn_s_waitcnt(0);
        unsigned nloc = b.st[0], nx = b.st[1];
        if (nloc == 0u) { xcd_barrier_complete(bar, b.x, nloc, nx); b.st[0] = nloc; b.st[1] = nx; }
        const unsigned old = xb_add(&bar[XB_XSUB(b.x)], 1u);
        const unsigned gen = old / nloc;
        if (old + 1u == (gen + 1u) * nloc) {
            __builtin_amdgcn_fence(__ATOMIC_RELEASE, "agent");
            asm volatile("s_waitcnt vmcnt(0)" ::: "memory");
            const unsigned og = xb_add(&bar[XB_TOP], 1u);
            const unsigned tg = og / nx;
            if (og + 1u == (tg + 1u) * nx) xb_add(&bar[XB_TOPGEN], 1u);
            else XB_SPIN(xb_ld(&bar[XB_TOPGEN]) == tg, bar);
            __builtin_amdgcn_fence(__ATOMIC_ACQUIRE, "agent");
            xb_add(&bar[XB_XGEN(b.x)], 1u);
            asm volatile("s_waitcnt vmcnt(0)" ::: "memory");
        } else {
            XB_SPIN(xb_ld(&bar[XB_XGEN(b.x)]) == gen, bar);
            __builtin_amdgcn_fence(__ATOMIC_ACQUIRE, "agent");
            asm volatile("s_waitcnt vmcnt(0)" ::: "memory");
        }
    }
    __syncthreads();
}

struct Frame {
    LAS unsigned char* lds;
    volatile LAS unsigned* MISC;
    gu32* ctl;
    int tid, lane, wave;
    int vcu, G;
    unsigned char* ws;
    const float *x, *c, *w_ada, *b_ada, *norm1_g, *w_in, *fox_q_norm, *fox_k_norm, *fox_f_bias, *gdn_conv_w, *gdn_a_log, *gdn_dt_bias, *gdn_norm_w, *w_out, *norm2_g, *w_gate, *w_up, *w_down;
    float* out;
};
__device__ __forceinline__ float wave_sum(float v) {
#pragma unroll
    for (int o = 1; o < 64; o <<= 1) v += __shfl_xor(v, o);
    return v;
}
__device__ __forceinline__ float sum16(float v) {
#pragma unroll
    for (int o = 1; o < 16; o <<= 1) v += __shfl_xor(v, o);
    return v;
}

template <bool NT> __device__ __forceinline__ void ada_task(Frame& F, int ks, int nc, int lane) {
    float* modp = (float*)(F.ws + WS_MODP);
    const int n = nc * 256 + lane * 4, k0 = ks * (DM / ADA_KS);
    const float* wp = F.w_ada + (size_t)k0 * NMOD + n;
    LAS unsigned char* scr = F.lds + RING_OFF + F.wave * 16640;
    f32x4 a0 = {0.f, 0.f, 0.f, 0.f}, a1 = {0.f, 0.f, 0.f, 0.f};
#define ADA_ISSUE(src, buf) do { _Pragma("unroll") for (int r_ = 0; r_ < 8; ++r_) \
        __builtin_amdgcn_global_load_lds((const unsigned*)((src) + (size_t)r_ * NMOD), (LAS unsigned*)((buf) + r_ * 1024), 16, 0, NT ? 2 : 0); } while (0)
#define ADA_EAT(buf, kb) do { _Pragma("unroll") for (int r = 0; r < 8; ++r) { const f32x4 w = *(const LAS f32x4*)((buf) + r * 1024 + lane * 16); \
        const float c0 = __builtin_bit_cast(float, __builtin_amdgcn_readlane(__builtin_bit_cast(int, c0v), (kb) + r)), c1 = __builtin_bit_cast(float, __builtin_amdgcn_readlane(__builtin_bit_cast(int, c1v), (kb) + r)); \
        a0 += w * c0; a1 += w * c1; } \
        asm volatile("s_waitcnt lgkmcnt(0)" ::: "memory"); } while (0)
    const float c0v = siluf_(F.c[k0 + lane]), c1v = siluf_(F.c[DM + k0 + lane]);
    ADA_ISSUE(wp, scr);
#pragma unroll 1
    for (int bt = 0; bt < 7; ++bt) {
        LAS unsigned char* cur = scr + (bt & 1) * 8192; LAS unsigned char* nxt = scr + ((bt + 1) & 1) * 8192;
        ADA_ISSUE(wp + (size_t)(bt + 1) * 8 * NMOD, nxt); asm volatile("s_waitcnt vmcnt(8)" ::: "memory");
        ADA_EAT(cur, bt * 8);
    }
    asm volatile("s_waitcnt vmcnt(0)" ::: "memory");
    ADA_EAT(scr + 8192, 56);
#undef ADA_EAT
#undef ADA_ISSUE
    *(f32x4*)(modp + (size_t)(ks * 2 + 0) * NMOD + n) = a0;
    *(f32x4*)(modp + (size_t)(ks * 2 + 1) * NMOD + n) = a1;
}
template <bool NT> __device__ __forceinline__ void p0_ada(Frame& F, int nc_lo, int nc_hi, int widx, int nworkers) {
    const int gw = widx * NWAVES + F.wave, NGW = nworkers * NWAVES;
    const int ncn = nc_hi - nc_lo;
    for (int task = gw; task < ADA_KS * ncn; task += NGW) ada_task<NT>(F, task / ncn, nc_lo + task % ncn, F.lane);
}
struct TrItem { const float* colp; bf16* dst; int ldw, K; };
template <bool NT> __device__ __forceinline__ void tr_load(f32x4 (&v)[16], const TrItem& it, int lane) {
    const int kq = lane >> 4;
#pragma unroll
    for (int i = 0; i < 16; ++i) { const f32x4* p = (const f32x4*)(it.colp + (size_t)(4 * i + kq) * it.ldw);
        v[i] = it.colp ? (NT ? __builtin_nontemporal_load(p) : *p) : (f32x4){0.f, 0.f, 0.f, 0.f}; }
}
template <bool NT> __device__ __forceinline__ void tr_store(const f32x4 (&v)[16], const TrItem& it, LAS float* scr, int lane) {
    const int kq = lane >> 4, g = lane & 15;
#pragma unroll
    for (int i = 0; i < 16; ++i) { LAS float* d = scr + (4 * i + kq) * 65 + 4 * g; d[0] = v[i].x; d[1] = v[i].y; d[2] = v[i].z; d[3] = v[i].w; }
    LDS_WAIT(); asm volatile("" ::: "memory");
    const int c = lane >> 3, rr = lane & 7;
#pragma unroll
    for (int j = 0; j < 8; ++j) { const int n = 8 * j + rr; const LAS float* s = scr + (8 * c) * 65 + n;
        v4u o; o.x = pk2(s[0 * 65], s[1 * 65]); o.y = pk2(s[2 * 65], s[3 * 65]); o.z = pk2(s[4 * 65], s[5 * 65]); o.w = pk2(s[6 * 65], s[7 * 65]);
        GAS v4u* q = (GAS v4u*)(it.dst + (size_t)n * it.K + 8 * c); if (NT) __builtin_nontemporal_store(o, q); else *q = o; }
    LDS_WAIT(); asm volatile("" ::: "memory");
}
__device__ __forceinline__ int win_srccol(int n) {
    if (n < PC_G) return n;
    if (n < PC_Z) return SRC_G + (n - PC_G);
    if (n < NP) return SRC_Z + (n - PC_Z);
    if (n < NP + 16) return SRC_F + (n - NP);
    if (n < NP + 32) return SRC_A + (n - NP - 16);
    if (n < NP + 48) return SRC_B + (n - NP - 32);
    return -1;
}
__device__ __forceinline__ TrItem p0_item(Frame& F, int it, int g4) {
    constexpr int I_IN = (DM / 64) * (NPT / 64), I_OUT = (DM / 64) * (DM / 64), I_GU = (DM / 64) * (2 * FF / 64);
    bf16* win_t = (bf16*)(F.ws + WS_WIN); bf16* wout_t = (bf16*)(F.ws + WS_WOUT); bf16* wgu_t = (bf16*)(F.ws + WS_WGU); bf16* wd_t = (bf16*)(F.ws + WS_WD);
    TrItem t; int r = it;
    if (r < I_IN) { const int kb = r % (DM / 64), nb = r / (DM / 64); const int sc = win_srccol(nb * 64 + g4);
        t.colp = sc >= 0 ? F.w_in + (size_t)(kb * 64) * IN_COLS + sc : nullptr; t.ldw = IN_COLS; t.K = LDWIN; t.dst = win_t + (size_t)(nb * 64) * LDWIN + kb * 64; return t; } r -= I_IN;
    if (r < I_OUT) { const int kb = r % (DM / 64), nb = r / (DM / 64);
        t.colp = F.w_out + (size_t)(kb * 64) * DM + nb * 64 + g4; t.ldw = DM; t.K = LDWOUT; t.dst = wout_t + (size_t)(nb * 64) * LDWOUT + kb * 64; return t; } r -= I_OUT;
    if (r < I_GU) { const int kb = r % (DM / 64), nb = r / (DM / 64); const int n = nb * 64 + g4;
        const float* src = ((n >> 7) & 1) ? F.w_up : F.w_gate;
        t.colp = src + (size_t)(kb * 64) * FF + (n >> 8) * 128 + (n & 127); t.ldw = FF; t.K = LDWGU; t.dst = wgu_t + (size_t)(nb * 64) * LDWGU + kb * 64; return t; } r -= I_GU;
    { const int kb = r % (FF / 64), nb = r / (FF / 64);
        t.colp = F.w_down + (size_t)(kb * 64) * DM + nb * 64 + g4; t.ldw = DM; t.K = FF; t.dst = wd_t + (size_t)(nb * 64) * FF + kb * 64; return t; }
}
constexpr int P0_ITEMS_ALL = (DM / 64) * (NPT / 64) + (DM / 64) * (DM / 64) + (DM / 64) * (2 * FF / 64) + (FF / 64) * (DM / 64);
constexpr int P0_ITEMS_IN = (DM / 64) * (NPT / 64);
constexpr int P6_ADA_WGS = 32;
constexpr int P6_CONV_WGS = 64;
constexpr int P0_ITEMS_DOWN = (FF / 64) * (DM / 64) * 7 / 8;
template <bool NT> __device__ __forceinline__ void p0_weights(Frame& F, int lo, int NITEMS, int widx, int nworkers) {
    LAS float* scr = (LAS float*)(F.lds + RING_OFF + F.wave * 16640);
    const int gw = widx * NWAVES + F.wave, NGW = nworkers * NWAVES;
    const int g4 = (F.lane & 15) * 4;
    f32x4 va[16], vb[16];
    int it = lo + gw; if (it >= NITEMS) return;
    TrItem ta = p0_item(F, it, g4), tb = ta;
    tr_load<NT>(va, ta, F.lane);
    for (;;) {
        const bool hb = it + NGW < NITEMS;
        if (hb) { tb = p0_item(F, it + NGW, g4); tr_load<NT>(vb, tb, F.lane); }
        tr_store<NT>(va, ta, scr, F.lane);
        if (!hb) break;
        const bool ha = it + 2 * NGW < NITEMS;
        if (ha) { ta = p0_item(F, it + 2 * NGW, g4); tr_load<NT>(va, ta, F.lane); }
        tr_store<NT>(vb, tb, scr, F.lane);
        if (!ha) break;
        it += 2 * NGW;
    }
}
__device__ __forceinline__ void p1_modreduce(Frame& F, int n_lo, int n_hi) {
    const float* modp = (const float*)(F.ws + WS_MODP); float* mod = (float*)(F.ws + WS_MOD);
    const int nn = n_hi - n_lo, ntask = 2 * nn / 64;
    LAS float* red = (LAS float*)(F.lds + RING_OFF);
    for (int task = F.vcu; task < ntask; task += F.G) {
        const int b = task / (nn / 64), n = n_lo + (task % (nn / 64)) * 64 + F.lane;
        const float* p = modp + (size_t)(F.wave * 8 * 2 + b) * NMOD + n;
        float v[8];
#pragma unroll
        for (int k = 0; k < 8; ++k) v[k] = p[(size_t)k * 2 * NMOD];
        red[F.wave * 64 + F.lane] = ((v[0] + v[1]) + (v[2] + v[3])) + ((v[4] + v[5]) + (v[6] + v[7]));
        __syncthreads();
        if (F.wave == 0) { float s = F.b_ada[n];
#pragma unroll
            for (int w = 0; w < NWAVES; ++w) s += red[w * 64 + F.lane];
            mod[(size_t)b * NMOD + n] = s; }
        __syncthreads();
    }
}
__device__ __forceinline__ void norm_mod_stage(Frame& F, const float* gain, int shift_chunk, int scale_chunk) {
    const float* mod = (const float*)(F.ws + WS_MOD);
    LAS f32x4* A4 = (LAS f32x4*)(F.lds + RING_OFF); LAS f32x4* S4 = A4 + 2 * (DM / 4);
#pragma unroll 1
    for (int b = 0; b < 2; ++b)
#pragma unroll 1
        for (int c4 = F.tid; c4 < DM / 4; c4 += NWAVES * 64) {
            const f32x4 g = ((const f32x4*)gain)[c4], sc = ((const f32x4*)(mod + (size_t)b * NMOD + scale_chunk * DM))[c4], sh = ((const f32x4*)(mod + (size_t)b * NMOD + shift_chunk * DM))[c4];
            A4[b * (DM / 4) + c4] = g * (1.0f + sc); S4[b * (DM / 4) + c4] = sh; }
    __syncthreads();
}
__device__ __forceinline__ void norm_mod_rows(Frame& F, const float* src, int ldh) {
    const int gw = F.vcu * NWAVES + F.wave, NGW = F.G * NWAVES;
    bf16* H = (bf16*)(F.ws + WS_H);
    const LAS f32x4* A4 = (const LAS f32x4*)(F.lds + RING_OFF); const LAS f32x4* S4 = A4 + 2 * (DM / 4);
#pragma unroll 1
    for (int row = gw; row < M; row += NGW) {
        const int b = row / SEQ;
        const GAS f32x4* xr = (const GAS f32x4*)(src + (size_t)row * DM) + F.lane;
        f32x4 v[16]; float ss = 0.f;
#pragma unroll
        for (int j = 0; j < 16; ++j) { v[j] = xr[64 * j]; ss += (v[j].x * v[j].x + v[j].y * v[j].y) + (v[j].z * v[j].z + v[j].w * v[j].w); }
        const float rstd = 1.0f / sqrtf(wave_sum(ss) * (1.0f / DM) + EPS);
        const LAS f32x4* ap = A4 + b * (DM / 4) + F.lane; const LAS f32x4* sp = S4 + b * (DM / 4) + F.lane;
        GAS v2u* o8 = (GAS v2u*)(H + (size_t)row * ldh) + F.lane;
#pragma unroll
        for (int j = 0; j < 16; ++j) { const f32x4 y = (v[j] * rstd) * ap[64 * j] + sp[64 * j];
            v2u w; w.x = pk2(y.x, y.y); w.y = pk2(y.z, y.w); o8[64 * j] = w;
            if ((j & 3) == 3) asm volatile("" ::: "memory"); }
    }
}
__device__ __forceinline__ void norm_mod_rows_b16(Frame& F, const bf16* src, int ldh) {
    const int gw = F.vcu * NWAVES + F.wave, NGW = F.G * NWAVES;
    bf16* H = (bf16*)(F.ws + WS_H);
    const LAS f32x4* A4 = (const LAS f32x4*)(F.lds + RING_OFF); const LAS f32x4* S4 = A4 + 2 * (DM / 4);
#pragma unroll 1
    for (int row = gw; row < M; row += NGW) {
        const int b = row / SEQ;
        const GAS v4u* xr = (const GAS v4u*)(src + (size_t)row * DM) + F.lane;
        v4u v[8]; float ss = 0.f;
#pragma unroll
        for (int j = 0; j < 8; ++j) { v[j] = xr[64 * j];
            const float e0 = bflo(v[j].x), e1 = bfhi(v[j].x), e2 = bflo(v[j].y), e3 = bfhi(v[j].y), e4 = bflo(v[j].z), e5 = bfhi(v[j].z), e6 = bflo(v[j].w), e7 = bfhi(v[j].w);
            ss += ((e0 * e0 + e1 * e1) + (e2 * e2 + e3 * e3)) + ((e4 * e4 + e5 * e5) + (e6 * e6 + e7 * e7)); }
        const float rstd = 1.0f / sqrtf(wave_sum(ss) * (1.0f / DM) + EPS);
        const LAS f32x4* ap = A4 + b * (DM / 4) + 2 * F.lane; const LAS f32x4* sp = S4 + b * (DM / 4) + 2 * F.lane;
        GAS v4u* o8 = (GAS v4u*)(H + (size_t)row * ldh) + F.lane;
#pragma unroll
        for (int j = 0; j < 8; ++j) {
            const f32x4 x0 = {bflo(v[j].x), bfhi(v[j].x), bflo(v[j].y), bfhi(v[j].y)}, x1 = {bflo(v[j].z), bfhi(v[j].z), bflo(v[j].w), bfhi(v[j].w)};
            const f32x4 y0 = (x0 * rstd) * ap[128 * j] + sp[128 * j], y1 = (x1 * rstd) * ap[128 * j + 1] + sp[128 * j + 1];
            v4u w; w.x = pk2(y0.x, y0.y); w.y = pk2(y0.z, y0.w); w.z = pk2(y1.x, y1.y); w.w = pk2(y1.z, y1.w); o8[64 * j] = w;
            if ((j & 1) == 1) asm volatile("" ::: "memory"); }
    }
}
__device__ __forceinline__ void p4_post(Frame& F) {
    const int gw = F.vcu * NWAVES + F.wave, NGW = F.G * NWAVES;
    bf16* P = (bf16*)(F.ws + WS_P);
    float* GG = (float*)(F.ws + WS_GG); float* GB = (float*)(F.ws + WS_GB); float* FLS = (float*)(F.ws + WS_FLS);
    const int l16 = F.lane & 15, sub = F.lane >> 4;
    for (int row = gw; row < M; row += NGW) {
        const int b = row / SEQ, t = row % SEQ;
        if (F.lane < 48) {
            const float* sp = (const float*)(F.ws + WS_SP) + (size_t)row * 64 + F.lane;
            float v = 0.f;
#pragma unroll
            for (int ks = 0; ks < 8; ++ks) v += sp[(size_t)ks * M * 64];
            const int h = F.lane & 15; const size_t o = (size_t)(b * NH + h) * SEQ + t;
            if (F.lane < 16) { const float z = v + F.fox_f_bias[h]; FLS[o] = (z < 0.f ? z : 0.f) - log1pf(expf(-fabsf(z))); }
            else if (F.lane < 32) { const float xs = v + F.gdn_dt_bias[h]; const float sp_ = xs > 20.f ? xs : log1pf(expf(xs)); GG[o] = -expf(F.gdn_a_log[h]) * sp_; }
            else GB[o] = 1.0f / (1.0f + expf(-v));
        }
    }
}
__device__ __forceinline__ void p5_kx(Frame& F) {
    for (int item = F.vcu; item < BATCH * NH * 8; item += F.G) {
        const int bh = item >> 3, sg = item & 7;
        const float* fls = (const float*)(F.ws + WS_FLS) + (size_t)bh * SEQ; bf16* KX = (bf16*)(F.ws + WS_KX);
        float pre = 0.f;
#pragma unroll
        for (int j = 0; j < 14; ++j) { const bool ok = j < 2 * sg;
            const f32x4 v = *(const f32x4*)(fls + (size_t)(ok ? F.lane * 2 * sg + j : 0) * 4); pre += ok ? (v.x + v.y) + (v.z + v.w) : 0.f; }
        pre = wave_sum(pre);
        const float* fp = fls + sg * 512 + F.lane * 8;
        const f32x4 v0 = *(const f32x4*)fp, v1 = *(const f32x4*)(fp + 4);
        float ls[8]; float tot = 0.f;
        tot += v0.x; ls[0] = tot; tot += v0.y; ls[1] = tot; tot += v0.z; ls[2] = tot; tot += v0.w; ls[3] = tot;
        tot += v1.x; ls[4] = tot; tot += v1.y; ls[5] = tot; tot += v1.z; ls[6] = tot; tot += v1.w; ls[7] = tot;
        float incl = tot;
#pragma unroll
        for (int o = 1; o < 64; o <<= 1) { const float u = __shfl_up(incl, o); if (F.lane >= o) incl += u; }
        const float base = pre + incl - tot;
        GAS v4u* kx = (GAS v4u*)(KX + ((size_t)bh * SEQ + sg * 512 + F.lane * 8) * 8);
#pragma unroll
        for (int i = 0; i < 8; ++i) { const float xj = -11.313708498984761f * (base + ls[i]);
            const unsigned hi_ = f2bf(xj); const float r1 = xj - __builtin_bit_cast(float, hi_ << 16);
            const unsigned mid_ = f2bf(r1); const float r2 = r1 - __builtin_bit_cast(float, mid_ << 16);
            const unsigned lo_ = f2bf(r2);
            v4u w; w.x = hi_ | (mid_ << 16); w.y = lo_; w.z = 0u; w.w = 0u; kx[i] = w; }
    }
}
__device__ __forceinline__ fox::BlockRef fox_ref(int bh, int qb) {
    const int b = bh / NH, h = bh % NH;
    fox::BlockRef r;
    r.q = (unsigned)((b * SEQ + qb * 256) * NPP + PC_Q + h * HD);
    r.k = (unsigned)((b * SEQ) * NPP + PC_K + h * HD);
    r.v = (unsigned)((b * SEQ) * NPP + PC_V + h * HD);
    r.kx = (unsigned)(bh * SEQ);
    r.o = (unsigned)((b * SEQ + qb * 256) * LDMIX + h * HD);
    r.P0 = qb * 256;
    return r;
}
__device__ __forceinline__ fox::BlockRef fox_item(int L) { return fox_ref(L & 31, 15 - (L >> 5)); }
__device__ __forceinline__ int fox_fetch(Frame& F) {
    __syncthreads();
    if (F.tid == 0) F.MISC[16] = __hip_atomic_fetch_add(F.ctl + CW_QUEUE, 1u, RLX_AGENT);
    __syncthreads();
    return (int)F.MISC[16];
}
__device__ __forceinline__ void p5_fox(Frame& F, char* lds) {
    constexpr int TOTAL = BATCH * NH * (SEQ / 256);
    int cur = fox_fetch(F); if (cur >= TOTAL) return;
    int nxt = fox_fetch(F);
    const fox::Bases Bs{(const bf16*)(F.ws + WS_P), (const bf16*)(F.ws + WS_KX), (bf16*)(F.ws + WS_MIX)};
    fox::Seam S;
    { const fox::BlockRef c0 = fox_item(cur); fox::fox_prime<NPP, LDMIX>(Bs, c0, lds, S); }
    for (;;) {
        const bool has_next = nxt < TOTAL;
        const fox::BlockRef c = fox_item(cur), nx = fox_item(has_next ? nxt : cur);
        fox::fox_block<NPP, LDMIX>(Bs, c, nx, lds, S);
        if (!has_next) break;
        cur = nxt; nxt = fox_fetch(F);
    }
}
__device__ __forceinline__ void p6_gdn_out(Frame& F) {
    const int gw = F.vcu * NWAVES + F.wave, NGW = F.G * NWAVES;
    const bf16* P = (const bf16*)(F.ws + WS_P); bf16* MIX = (bf16*)(F.ws + WS_MIX); const bf16* GO = (const bf16*)(F.ws + WS_GO);
    const int l16 = F.lane & 15, sub = F.lane >> 4;
    for (int row = gw; row < M; row += NGW) {
        const int b = row / SEQ, t = row % SEQ;
#pragma unroll
        for (int it = 0; it < 4; ++it) {
            const int h = it * 4 + sub;
            const v4u ow = *(const GAS v4u*)(GO + ((size_t)(b * NH + h) * SEQ + t) * HD + l16 * 8);
            const f32x4 o0 = {bflo(ow.x), bfhi(ow.x), bflo(ow.y), bfhi(ow.y)}, o1 = {bflo(ow.z), bfhi(ow.z), bflo(ow.w), bfhi(ow.w)};
            const v4u zw = *(const GAS v4u*)(P + (size_t)row * NPP + PC_Z + h * HD + l16 * 8);
            float ss = (o0.x * o0.x + o0.y * o0.y) + (o0.z * o0.z + o0.w * o0.w) + (o1.x * o1.x + o1.y * o1.y) + (o1.z * o1.z + o1.w * o1.w);
            const float rstd = 1.0f / sqrtf(sum16(ss) * (1.0f / HD) + EPS);
            const float* gn = F.gdn_norm_w + l16 * 8; const f32x4 g0 = *(const f32x4*)gn, g1 = *(const f32x4*)(gn + 4);
            v4u w;
            w.x = pk2(o0.x * rstd * g0.x * siluf_(bflo(zw.x)), o0.y * rstd * g0.y * siluf_(bfhi(zw.x)));
            w.y = pk2(o0.z * rstd * g0.z * siluf_(bflo(zw.y)), o0.w * rstd * g0.w * siluf_(bfhi(zw.y)));
            w.z = pk2(o1.x * rstd * g1.x * siluf_(bflo(zw.z)), o1.y * rstd * g1.y * siluf_(bfhi(zw.z)));
            w.w = pk2(o1.z * rstd * g1.z * siluf_(bflo(zw.w)), o1.w * rstd * g1.w * siluf_(bfhi(zw.w)));
            *(GAS v4u*)(MIX + (size_t)row * LDMIX + FOXW + h * HD + l16 * 8) = w;
        }
    }
}

typedef short gbf16x8 __attribute__((ext_vector_type(8)));
typedef float gf32x16 __attribute__((ext_vector_type(16)));
typedef float gf32x2 __attribute__((ext_vector_type(2))); typedef __bf16 gbf16x2 __attribute__((ext_vector_type(2)));
__device__ __forceinline__ unsigned gcvtpk(float lo, float hi) { gf32x2 v = {lo, hi}; gbf16x2 b = __builtin_convertvector(v, gbf16x2); return __builtin_bit_cast(unsigned, b); }
__device__ __forceinline__ gbf16x8 gpack8(f32x4 a, f32x4 b) { v4u w = {gcvtpk(a[0], a[1]), gcvtpk(a[2], a[3]), gcvtpk(b[0], b[1]), gcvtpk(b[2], b[3])}; return __builtin_bit_cast(gbf16x8, w); }
__device__ __forceinline__ int gcrow(int r, int hi) { return (r & 3) + 8 * (r >> 2) + 4 * hi; }
__device__ __forceinline__ float gbf(unsigned short h) { return __builtin_bit_cast(float, (unsigned)h << 16); }
constexpr int GP_TAB = 0, GP_AMAT = 2048, GP_TB = GP_AMAT + 17408, GP_TILES = GP_TB + 9216, GP_TS = 272, GP_TILE = 64 * GP_TS, GP_SET = 3 * GP_TILE;
constexpr int GP_CW = GP_TILES + 2 * GP_SET;
static_assert(GP_CW + 6144 <= PHASE_LDS, "chunk-prep LDS map");
__device__ __forceinline__ void gp_tables(Frame& F, int cidx, LAS float* Gs, int lane) {
    const float* GG = (const float*)(F.ws + WS_GG); const float* GB = (const float*)(F.ws + WS_GB); float* GT = (float*)(F.ws + WS_GT);
    const size_t tok0 = (size_t)(cidx >> 6) * SEQ + (cidx & 63) * 64;
    const float gi = GG[tok0 + lane], bi = GB[tok0 + lane];
    float G = gi;
#pragma unroll
    for (int o = 1; o < 64; o <<= 1) { const float u = __shfl_up(G, o); if (lane >= o) G += u; }
    const float G63 = __shfl(G, 63);
    Gs[lane] = G; Gs[64 + lane] = bi; Gs[128 + lane] = __expf(G); Gs[192 + lane] = __expf(G63 - G);
    if (lane == 63) GT[cidx] = __expf(G);
    const int h = (cidx >> 6) & 15; LAS float* cwl = (LAS float*)(F.lds + GP_CW);
#pragma unroll
    for (int r = 0; r < 12; ++r) { const int type = r >> 2, tap = r & 3;
        const float* src = F.gdn_conv_w + (size_t)tap * 6144 + type * GDNW + h * HD + 2 * lane;
        cwl[r * 128 + 2 * lane] = src[0]; cwl[r * 128 + 2 * lane + 1] = src[1]; }
}
template <int NW> struct GpTaps { static constexpr int NP_ = (192 + 4 * NW - 1) / (4 * NW); v4u xw[NP_][4]; };
template <int NW>
__device__ __forceinline__ void gp_stage0_load(Frame& F, int cidx, int w, int lane, GpTaps<NW>& tp) {

    constexpr int NP_ = (192 + 4 * NW - 1) / (4 * NW);
    const bf16* P = (const bf16*)(F.ws + WS_P);
    const int c = lane & 15, sub = lane >> 4;
    const int bh = cidx >> 6, n = cidx & 63, b = bh >> 4, h = bh & 15;
#pragma unroll
    for (int it = 0; it < NP_; ++it) {
        int pi = it * 4 * NW + 4 * w + sub; if (pi > 191) pi = 191;
        const int type = pi >> 6, i = pi & 63, t = n * 64 + i;
        const bf16* prow = P + (size_t)(b * SEQ + t) * NPP + PC_G + type * GDNW + h * HD + c * 8;
#pragma unroll
        for (int tap = 0; tap < 4; ++tap) { const int dt = 3 - tap; const bool ok = t - dt >= 0;
            tp.xw[it][tap] = *(const GAS v4u*)(prow - (size_t)(ok ? dt : 0) * NPP);
            if (!ok) tp.xw[it][tap] = (v4u){0u, 0u, 0u, 0u}; }
    }
}
template <int NW>
__device__ __forceinline__ void gp_stage0_compute(Frame& F, int cidx, const LAS float* Gs, LAS unsigned char* tiles, int w, int lane, const GpTaps<NW>& tp) {

    constexpr int NP_ = (192 + 4 * NW - 1) / (4 * NW);
    const int c = lane & 15, sub = lane >> 4;
    const int bh = cidx >> 6, n = cidx & 63, b = bh >> 4, h = bh & 15;
    unsigned char* CH = F.ws + WS_CH + (size_t)cidx * CH_BYTES;
    const LAS float* cwl = (const LAS float*)(F.lds + GP_CW);
#pragma unroll
    for (int it = 0; it < NP_; ++it) {
        const int pi = it * 4 * NW + 4 * w + sub;
        if (pi < 192) {
            const int type = pi >> 6, i = pi & 63;
            float acc[8];
#pragma unroll
            for (int e = 0; e < 8; ++e) acc[e] = 0.f;
#pragma unroll
            for (int tap = 0; tap < 4; ++tap) {
                const v4u xv = tp.xw[it][tap];
                const LAS float* cw = cwl + (type * 4 + tap) * 128 + c * 8;
                const f32x4 c0 = *(const LAS f32x4*)cw, c1 = *(const LAS f32x4*)(cw + 4);
                acc[0] += bflo(xv.x) * c0.x; acc[1] += bfhi(xv.x) * c0.y; acc[2] += bflo(xv.y) * c0.z; acc[3] += bfhi(xv.y) * c0.w;
                acc[4] += bflo(xv.z) * c1.x; acc[5] += bfhi(xv.z) * c1.y; acc[6] += bflo(xv.w) * c1.z; acc[7] += bfhi(xv.w) * c1.w;
            }
            float ss = 0.f;
#pragma unroll
            for (int e = 0; e < 8; ++e) { acc[e] = siluf_(acc[e]); ss += acc[e] * acc[e]; }
            ss = sum16(ss);
            float sc = 1.0f;
            if (type < 2) sc = __builtin_amdgcn_rsqf(ss + EPS);
            if (type == 0) sc *= 0.08838834764831845f;
#pragma unroll
            for (int e = 0; e < 8; ++e) acc[e] *= sc;
            const v4u o = {gcvtpk(acc[0], acc[1]), gcvtpk(acc[2], acc[3]), gcvtpk(acc[4], acc[5]), gcvtpk(acc[6], acc[7])};
            *(LAS v4u*)(tiles + type * GP_TILE + i * GP_TS + c * 16) = o;
            if (type == 0) {
                const float e_ = Gs[128 + i];
                v2u w0 = {gcvtpk(acc[0] * e_, acc[1] * e_), gcvtpk(acc[2] * e_, acc[3] * e_)}, w1 = {gcvtpk(acc[4] * e_, acc[5] * e_), gcvtpk(acc[6] * e_, acc[7] * e_)};
                *(GAS v2u*)(CH + CH_Q + i * RS_W + c * 16) = w0; *(GAS v2u*)(CH + CH_Q + i * RS_W + c * 16 + 8) = w1;
            }
        }
        asm volatile("" ::: "memory");
    }
}
template <int NW>
__device__ __forceinline__ void gp_stage0(Frame& F, int cidx, const LAS float* Gs, LAS unsigned char* tiles, int w, int lane) { GpTaps<NW> tp; gp_stage0_load<NW>(F, cidx, w, lane, tp); gp_stage0_compute<NW>(F, cidx, Gs, tiles, w, lane, tp); }
#ifndef GP_PROBE
#define GP_PROBE 0
#endif
#define GP_BAR() do { asm volatile("s_waitcnt lgkmcnt(0)" ::: "memory"); __builtin_amdgcn_s_barrier(); asm volatile("" ::: "memory"); } while (0)
__device__ __forceinline__ void gdn_chunk_prep(Frame& F) {
    LAS float* Amat = (LAS float*)(F.lds + GP_AMAT);
    LAS bf16* Tb = (LAS bf16*)(F.lds + GP_TB);
    constexpr int TS = GP_TS;
    const int wave = F.wave;
    int cidx = F.vcu; if (cidx >= NCHUNK) return;
    { int tid0 = F.tid; asm volatile("" : "+v"(tid0)); const int lane0 = tid0 & 63;
      if (wave == 0) gp_tables(F, cidx, (LAS float*)(F.lds + GP_TAB), lane0);
      else if (wave == 7) p5_kx(F);
      GP_BAR();
      gp_stage0<8>(F, cidx, (const LAS float*)(F.lds + GP_TAB), F.lds + GP_TILES, wave, lane0);
      GP_BAR(); }
    for (int k = 0; cidx < NCHUNK; cidx += F.G, ++k) {
        int tid_ = F.tid; asm volatile("" : "+v"(tid_));
        const int lane = tid_ & 63, r32 = lane & 31, hi = lane >> 5;
        const int cur = k & 1, ncidx = cidx + F.G; const bool has_next = ncidx < NCHUNK;
        const LAS float* Gs = (const LAS float*)(F.lds + GP_TAB + cur * 1024); const LAS float* Bs = Gs + 64; const LAS float* EGs = Gs + 128; const LAS float* EGTs = Gs + 192;
        LAS unsigned char* qs = F.lds + GP_TILES + cur * GP_SET; LAS unsigned char* ks = qs + GP_TILE; LAS unsigned char* vs = ks + GP_TILE;
        unsigned char* CH = F.ws + WS_CH + (size_t)cidx * CH_BYTES;
        for (int rep_ = 0; rep_ < ((GP_PROBE & 1) ? 2 : 1); ++rep_)
        if (wave < 6) {
            const int typ = wave / 3, blk = wave % 3, I = blk ? 1 : 0, J = blk == 2 ? 1 : 0;
            const LAS unsigned char* Ap = (typ ? qs : ks) + (32 * I + r32) * TS + hi * 16;
            const LAS unsigned char* Bp = ks + (32 * J + r32) * TS + hi * 16;
            gf32x16 acc = {};
#pragma unroll
            for (int kk = 0; kk < 8; ++kk) {
                const gbf16x8 a = *(const LAS gbf16x8*)(Ap + kk * 32), bq = *(const LAS gbf16x8*)(Bp + kk * 32);
                acc = __builtin_amdgcn_mfma_f32_32x32x16_bf16(a, bq, acc, 0, 0, 0);
            }
            const int j = 32 * J + r32; const float Gj = Gs[j];
#pragma unroll
            for (int q = 0; q < 16; ++q) {
                const int i = 32 * I + gcrow(q, hi);
                const float val = acc[q] * __expf(Gs[i] - Gj);
                if (typ == 0) { if (i > j) Amat[i * 68 + j] = Bs[i] * val; }
                else { *(LAS bf16*)((LAS unsigned char*)Tb + i * RS_K + j * 2) = (bf16)f2bf(i >= j ? val : 0.f); }
            }
        } else {
            const int t = tid_ - 384;
#pragma unroll 4
            for (int ig = 0; ig < 16; ++ig) {
                const float x0 = gbf(*(const LAS bf16*)(ks + (4 * ig) * TS + t * 2)) * EGTs[4 * ig], x1 = gbf(*(const LAS bf16*)(ks + (4 * ig + 1) * TS + t * 2)) * EGTs[4 * ig + 1];
                const float x2 = gbf(*(const LAS bf16*)(ks + (4 * ig + 2) * TS + t * 2)) * EGTs[4 * ig + 2], x3 = gbf(*(const LAS bf16*)(ks + (4 * ig + 3) * TS + t * 2)) * EGTs[4 * ig + 3];
                v2u w = {gcvtpk(x0, x1), gcvtpk(x2, x3)};
                *(GAS v2u*)(CH + CH_KT + t * RS_K + ig * 8) = w;
            }
        }
        GP_BAR();
        if (wave == 0) {
            float T[64];
#pragma unroll
            for (int i = 0; i < 50; i += 2) {
                float a = (i == lane) ? 1.f : 0.f, bq = (i + 1 == lane) ? 1.f : 0.f;
#pragma unroll
                for (int j = 0; j < i; ++j) { a = fmaf(-Amat[i * 68 + j], T[j], a); bq = fmaf(-Amat[(i + 1) * 68 + j], T[j], bq); }
                T[i] = a;
                T[i + 1] = fmaf(-Amat[(i + 1) * 68 + i], a, bq);
                asm volatile("" ::: "memory");
            }
            GP_BAR();
#pragma unroll
            for (int i = 50; i < 64; i += 2) {
                float a = (i == lane) ? 1.f : 0.f, bq = (i + 1 == lane) ? 1.f : 0.f;
#pragma unroll
                for (int j = 0; j < i; ++j) { a = fmaf(-Amat[i * 68 + j], T[j], a); bq = fmaf(-Amat[(i + 1) * 68 + j], T[j], bq); }
                T[i] = a;
                T[i + 1] = fmaf(-Amat[(i + 1) * 68 + i], a, bq);
                asm volatile("" ::: "memory");
            }
#pragma unroll
            for (int i = 0; i < 64; ++i) Tb[i * 72 + lane] = (bf16)f2bf(T[i]);
        } else {
            GpTaps<7> tp;
            gp_stage0_load<7>(F, has_next ? ncidx : cidx, wave - 1, lane, tp);
            if (wave == 1) { if (has_next) gp_tables(F, ncidx, (LAS float*)(F.lds + GP_TAB + (cur ^ 1) * 1024), lane); }
            else {
                const int t = tid_ - 128;
                for (int x = t; x < 544; x += 384) *(GAS v4u*)(CH + CH_AQ + x * 16) = *(const LAS v4u*)((LAS unsigned char*)Tb + x * 16);
                if (k > 0) { unsigned char* CHp = F.ws + WS_CH + (size_t)(cidx - F.G) * CH_BYTES; const LAS unsigned char* wi = F.lds + GP_TILES + (cur ^ 1) * GP_SET;
                    for (int x = t; x < 1056; x += 384) *(GAS v4u*)(CHp + CH_W + x * 16) = *(const LAS v4u*)(wi + x * 16); }
            }
            GP_BAR();
            if (has_next) gp_stage0_compute<7>(F, ncidx, (const LAS float*)(F.lds + GP_TAB + (cur ^ 1) * 1024), F.lds + GP_TILES + (cur ^ 1) * GP_SET, wave - 1, lane, tp);
        }
        GP_BAR();
        for (int rep_ = 0; rep_ < ((GP_PROBE & 4) ? 2 : 1); ++rep_) {
            const int nb = wave & 3, isU = wave >> 2;
            const LAS unsigned char* src = (isU ? vs : ks) + (32 * nb + r32) * 2;
            gf32x16 acc0 = {}, acc1 = {};
#pragma unroll
            for (int kk = 0; kk < 4; ++kk) {
                float x[8];
#pragma unroll
                for (int jj = 0; jj < 8; ++jj) { const int j = 16 * kk + 8 * hi + jj; const float sc = isU ? Bs[j] : Bs[j] * EGs[j]; x[jj] = gbf(*(const LAS bf16*)(src + j * TS)) * sc; }
                const v4u bw = {gcvtpk(x[0], x[1]), gcvtpk(x[2], x[3]), gcvtpk(x[4], x[5]), gcvtpk(x[6], x[7])};
                const gbf16x8 bq = __builtin_bit_cast(gbf16x8, bw);
                const gbf16x8 a0 = *(const LAS gbf16x8*)((LAS unsigned char*)Tb + r32 * 144 + (16 * kk + 8 * hi) * 2);
                const gbf16x8 a1 = *(const LAS gbf16x8*)((LAS unsigned char*)Tb + (32 + r32) * 144 + (16 * kk + 8 * hi) * 2);
                acc0 = __builtin_amdgcn_mfma_f32_32x32x16_bf16(a0, bq, acc0, 0, 0, 0);
                acc1 = __builtin_amdgcn_mfma_f32_32x32x16_bf16(a1, bq, acc1, 0, 0, 0);
            }
            if (isU) {
                float* up = (float*)(F.ws + WS_UC) + ((size_t)(cidx * 2 + 0) * 4 + nb) * 1024 + lane * 16;
#pragma unroll
                for (int v = 0; v < 4; ++v) { *(f32x4*)(up + 4 * v) = (f32x4){acc0[4 * v], acc0[4 * v + 1], acc0[4 * v + 2], acc0[4 * v + 3]};
                                              *(f32x4*)(up + 4096 + 4 * v) = (f32x4){acc1[4 * v], acc1[4 * v + 1], acc1[4 * v + 2], acc1[4 * v + 3]}; }
            } else {
#pragma unroll
                for (int q = 0; q < 16; ++q) { const int i = gcrow(q, hi);
                    *(LAS bf16*)(qs + i * RS_W + (32 * nb + r32) * 2) = (bf16)f2bf(-acc0[q]);
                    *(LAS bf16*)(qs + (32 + i) * RS_W + (32 * nb + r32) * 2) = (bf16)f2bf(-acc1[q]); }
            }
        }
        GP_BAR();
    }
    {
        int tid_ = F.tid; asm volatile("" : "+v"(tid_));
        const int last = cidx - F.G, kl = (last - F.vcu) / F.G;
        unsigned char* CHp = F.ws + WS_CH + (size_t)last * CH_BYTES; const LAS unsigned char* wi = F.lds + GP_TILES + (kl & 1) * GP_SET;
        for (int x = tid_; x < 1056; x += NWAVES * 64) *(GAS v4u*)(CHp + CH_W + x * 16) = *(const LAS v4u*)(wi + x * 16);
    }
}
#undef GP_BAR
__device__ __forceinline__ gbf16x8 gdn_ldfrag(const LAS unsigned char* p) {
    const v2u lo = *(const LAS v2u*)p, hi8 = *(const LAS v2u*)(p + 16);
    const v4u w = {lo.x, lo.y, hi8.x, hi8.y}; return __builtin_bit_cast(gbf16x8, w);
}
__device__ __forceinline__ gbf16x8 gdn_accfrag(const gf32x16& x, int s) {
    const v4u w = {gcvtpk(x[8 * s], x[8 * s + 1]), gcvtpk(x[8 * s + 2], x[8 * s + 3]), gcvtpk(x[8 * s + 4], x[8 * s + 5]), gcvtpk(x[8 * s + 6], x[8 * s + 7])};
    return __builtin_bit_cast(gbf16x8, w);
}
#define GDN_BAR() do { asm volatile("s_waitcnt lgkmcnt(0)" ::: "memory"); __builtin_amdgcn_s_barrier(); asm volatile("" ::: "memory"); } while (0)
__device__ __forceinline__ void gdn_scan(Frame& F, int bh) {
    const int lane = F.lane, wave = F.wave, c = lane & 31, hi = lane >> 5;
    const unsigned char* CHB = F.ws + WS_CH + (size_t)(bh * 64) * CH_BYTES;
    if (wave >= 4) {
        const unsigned char* src = CHB + (wave - 4) * 1024 + lane * 16;
#pragma unroll
        for (int i = 0; i < 15; ++i) __builtin_amdgcn_global_load_lds((const unsigned*)(src + i * 4096), (LAS unsigned*)(F.lds + (i * 4 + (wave - 4)) * 1024), 16, 0, 0);
        asm volatile("s_waitcnt vmcnt(0)" ::: "memory"); GDN_BAR();
        for (int n = 0; n < 64; ++n) {
            if (n + 1 < 64) { const unsigned char* s2 = src + (size_t)(n + 1) * CH_BYTES; const int boff = ((n + 1) & 1) * CH_BYTES;
#pragma unroll
                for (int i = 0; i < 15; ++i) __builtin_amdgcn_global_load_lds((const unsigned*)(s2 + i * 4096), (LAS unsigned*)(F.lds + boff + (i * 4 + (wave - 4)) * 1024), 16, 0, 0); }
            asm volatile("s_waitcnt vmcnt(0)" ::: "memory"); GDN_BAR();
        }
    } else {
        const float* UC = (const float*)(F.ws + WS_UC) + (size_t)(bh * 64) * 8192 + wave * 1024 + lane * 16;
        const float* GT = (const float*)(F.ws + WS_GT) + bh * 64;
        bf16* GO = (bf16*)(F.ws + WS_GO) + (size_t)bh * SEQ * HD + 32 * wave + c;
        const int roW = c * RS_W + hi * 8, roK = c * RS_K + hi * 8;
        gf32x16 S0 = {}, S1 = {}, S2 = {}, S3 = {};
        gbf16x8 Sb00, Sb01, Sb10, Sb11, Sb20, Sb21, Sb30, Sb31;
        Sb00 = (gbf16x8){0, 0, 0, 0, 0, 0, 0, 0}; Sb01 = Sb00; Sb10 = Sb00; Sb11 = Sb00; Sb20 = Sb00; Sb21 = Sb00; Sb30 = Sb00; Sb31 = Sb00;
        float gtn = GT[0];
        gf32x16 Un0 = *(const gf32x16*)UC, Un1 = *(const gf32x16*)(UC + 4096);
        GDN_BAR();
#define LDF(dst, base, o8) const gbf16x8 dst = gdn_ldfrag(Bp + (base) + (o8) * 8)
#define MF(acc, f, bop) acc = __builtin_amdgcn_mfma_f32_32x32x16_bf16(f, bop, acc, 0, 0, 0)
#define SB() __builtin_amdgcn_sched_barrier(0)
        for (int n = 0; n < 64; ++n) {
            const LAS unsigned char* Bp = F.lds + (n & 1) * CH_BYTES;
            const int bW0 = CH_W + roW, bW1 = bW0 + 32 * RS_W, bQ0 = CH_Q + roW, bQ1 = bQ0 + 32 * RS_W, bA0 = CH_AQ + roK, bA1 = bA0 + 32 * RS_K;
            const int bK0 = CH_KT + roK, bK1 = bK0 + 32 * RS_K, bK2 = bK0 + 64 * RS_K, bK3 = bK0 + 96 * RS_K;
            const float gt = gtn;
            gf32x16 V0 = Un0, V1 = Un1, O0 = {}, O1 = {};
            if (n + 1 < 64) { gtn = GT[n + 1]; SB(); Un0 = *(const gf32x16*)(UC + (size_t)(n + 1) * 8192); Un1 = *(const gf32x16*)(UC + (size_t)(n + 1) * 8192 + 4096); }
            SB();
            LDF(w00, bW0, 0); LDF(w01, bW1, 0); LDF(w02, bW0, 4); LDF(w03, bW1, 4); SB();
            LDF(w10, bW0, 8); LDF(w11, bW1, 8); LDF(w12, bW0, 12); LDF(w13, bW1, 12); SB();
            MF(V0, w00, Sb00); MF(V1, w01, Sb00); MF(V0, w02, Sb01); MF(V1, w03, Sb01); SB();
            LDF(w20, bW0, 16); LDF(w21, bW1, 16); LDF(w22, bW0, 20); LDF(w23, bW1, 20); SB();
            MF(V0, w10, Sb10); MF(V1, w11, Sb10); MF(V0, w12, Sb11); MF(V1, w13, Sb11); SB();
            LDF(w30, bW0, 24); LDF(w31, bW1, 24); LDF(w32, bW0, 28); LDF(w33, bW1, 28); SB();
            MF(V0, w20, Sb20); MF(V1, w21, Sb20); MF(V0, w22, Sb21); MF(V1, w23, Sb21); SB();
            LDF(q00, bQ0, 0); LDF(q01, bQ1, 0); LDF(q02, bQ0, 4); LDF(q03, bQ1, 4); SB();
            MF(V0, w30, Sb30); MF(V1, w31, Sb30); MF(V0, w32, Sb31); MF(V1, w33, Sb31); SB();
            LDF(q10, bQ0, 8); LDF(q11, bQ1, 8); LDF(q12, bQ0, 12); LDF(q13, bQ1, 12); SB();
            MF(O0, q00, Sb00); MF(O1, q01, Sb00); MF(O0, q02, Sb01); MF(O1, q03, Sb01); SB();
            LDF(q20, bQ0, 16); LDF(q21, bQ1, 16); LDF(q22, bQ0, 20); LDF(q23, bQ1, 20); SB();
            MF(O0, q10, Sb10); MF(O1, q11, Sb10); MF(O0, q12, Sb11); MF(O1, q13, Sb11); S0 = S0 * gt; S1 = S1 * gt; SB();
            LDF(q30, bQ0, 24); LDF(q31, bQ1, 24); LDF(q32, bQ0, 28); LDF(q33, bQ1, 28); SB();
            MF(O0, q20, Sb20); MF(O1, q21, Sb20); MF(O0, q22, Sb21); MF(O1, q23, Sb21); S2 = S2 * gt; S3 = S3 * gt; SB();
            LDF(x0, bA0, 0); LDF(x1, bA1, 0); LDF(x2, bA1, 8); LDF(x3, bA0, 4); SB();
            MF(O0, q30, Sb30); MF(O1, q31, Sb30); MF(O0, q32, Sb31); MF(O1, q33, Sb31); SB();
            const gbf16x8 Vb00 = gdn_accfrag(V0, 0), Vb01 = gdn_accfrag(V0, 1), Vb10 = gdn_accfrag(V1, 0), Vb11 = gdn_accfrag(V1, 1);
            LDF(x4, bA1, 4); LDF(x5, bA1, 12); LDF(k00, bK0, 0); LDF(k01, bK1, 0); SB();
            MF(O0, x0, Vb00); MF(O1, x1, Vb00); MF(O1, x2, Vb10); MF(O0, x3, Vb01); SB();
            LDF(k02, bK2, 0); LDF(k03, bK3, 0); LDF(k10, bK0, 4); LDF(k11, bK1, 4); SB();
            MF(O1, x4, Vb01); MF(O1, x5, Vb11);
            MF(S0, k00, Vb00); MF(S1, k01, Vb00); SB();
            LDF(k12, bK2, 4); LDF(k13, bK3, 4); LDF(k20, bK0, 8); LDF(k21, bK1, 8); SB();
            MF(S2, k02, Vb00); MF(S3, k03, Vb00); MF(S0, k10, Vb01); MF(S1, k11, Vb01); SB();
            LDF(k22, bK2, 8); LDF(k23, bK3, 8); LDF(k30, bK0, 12); LDF(k31, bK1, 12); SB();
            MF(S2, k12, Vb01); MF(S3, k13, Vb01); MF(S0, k20, Vb10); MF(S1, k21, Vb10); SB();
            LDF(k32, bK2, 12); LDF(k33, bK3, 12); SB();
            MF(S2, k22, Vb10); MF(S3, k23, Vb10); MF(S0, k30, Vb11); MF(S1, k31, Vb11); SB();
            MF(S2, k32, Vb11); MF(S3, k33, Vb11); SB();
            bf16* op = GO + (size_t)(n * 64) * HD;
#pragma unroll
            for (int q = 0; q < 16; ++q) { const int i = gcrow(q, hi); op[(size_t)i * HD] = (bf16)gcvtpk(O0[q], O0[q]); op[(size_t)(32 + i) * HD] = (bf16)gcvtpk(O1[q], O1[q]); }
            Sb00 = gdn_accfrag(S0, 0); Sb01 = gdn_accfrag(S0, 1); Sb10 = gdn_accfrag(S1, 0); Sb11 = gdn_accfrag(S1, 1);
            Sb20 = gdn_accfrag(S2, 0); Sb21 = gdn_accfrag(S2, 1); Sb30 = gdn_accfrag(S3, 0); Sb31 = gdn_accfrag(S3, 1);
            GDN_BAR();
        }
#undef LDF
#undef MF
#undef SB
    }
}
#undef GDN_BAR
struct Args { const float* in[18]; float* out; unsigned char* ws; int ph_lo, ph_hi; };
__global__ void __launch_bounds__(NWAVES * 64, 2) hyb_fwd(Args args) {
    extern __shared__ __attribute__((aligned(16))) unsigned char lds[];
    Frame F;
    F.lds = (LAS unsigned char*)lds;
    F.MISC = (volatile LAS unsigned*)(F.lds + MISC_OFF);
    F.tid = threadIdx.x; F.lane = F.tid & 63; F.wave = __builtin_amdgcn_readfirstlane(F.tid >> 6);
    F.G = gridDim.x; { const int bx = blockIdx.x; F.vcu = (F.G % 8 == 0) ? (bx % 8) * (F.G / 8) + bx / 8 : bx; }
    F.ws = args.ws; F.ctl = (gu32*)(args.ws + WS_CTL);
    F.x = args.in[0]; F.c = args.in[1]; F.w_ada = args.in[2]; F.b_ada = args.in[3]; F.norm1_g = args.in[4]; F.w_in = args.in[5]; F.fox_q_norm = args.in[6]; F.fox_k_norm = args.in[7];
    F.fox_f_bias = args.in[8]; F.gdn_conv_w = args.in[9]; F.gdn_a_log = args.in[10]; F.gdn_dt_bias = args.in[11]; F.gdn_norm_w = args.in[12]; F.w_out = args.in[13]; F.norm2_g = args.in[14];
    F.w_gate = args.in[15]; F.w_up = args.in[16]; F.w_down = args.in[17]; F.out = args.out;
    for (int u = F.tid; u < (LDS_BYTES - LDSCTL_OFF) / 4; u += NWAVES * 64) ((LAS unsigned*)(F.lds + LDSCTL_OFF))[u] = 0u;
    __syncthreads();
    const int lo = args.ph_lo, hi = args.ph_hi;
    const bool fusedrun = (hi - lo) > 1;
    XcdBarrier bar; bar.bar = (unsigned*)(F.ctl + CW_BAR); bar.x = 0; bar.st = nullptr;
    if (fusedrun) bar = xcd_barrier_post((unsigned*)(F.ctl + CW_BAR), F.MISC + 8);
#ifndef PHASE_MASK
#define PHASE_MASK 0xfff
#endif
#define IN(k) (((PHASE_MASK >> (k)) & 1) && lo <= (k) && (k) < hi)
#define REFRESH() do { int t_ = threadIdx.x; asm volatile("" : "+v"(t_)); F.tid = t_; F.lane = t_ & 63; F.wave = __builtin_amdgcn_readfirstlane(t_ >> 6); } while (0)
#define SEAM(k) do { if (IN(k) && IN((k) + 1)) xcd_barrier(bar); } while (0)
    bf16* H = (bf16*)(args.ws + WS_H); bf16* P = (bf16*)(args.ws + WS_P); bf16* MIX = (bf16*)(args.ws + WS_MIX); bf16* HID = (bf16*)(args.ws + WS_HID); bf16* X1 = (bf16*)(args.ws + WS_X1);
    const float* MOD = (const float*)(args.ws + WS_MOD);

#ifndef REP_MASK
#define REP_MASK 0
#endif
#ifndef REPN
#define REPN 1
#endif
#define REP(k) (((REP_MASK >> (k)) & 1) && fusedrun)
#ifndef PRE_EPI
#define PRE_EPI EpiBf16<0>
#define PRE_EPI_INIT {P, NPP, nullptr, 0, 0, 1.f}
#endif
#ifndef PRE_K
#define PRE_K 0
#endif
#ifndef PRE_K10
#define PRE_K10 0
#endif
#ifndef SIDE_REP
#define SIDE_REP 1
#endif
struct InProjOrder : pg8::StaticOrder {
    __device__ bool next(int i, pg8::Unit& u) const { if (!pg8::StaticOrder::next(i, u)) return false;
        if (u.pn >= 8 && u.pn < 16) u.pn += 20; else if (u.pn >= 28 && u.pn < 36) u.pn -= 20; return true; }
};
#define LATE_OK ((int)F.G >= BATCH * NH + P6_CONV_WGS + P6_ADA_WGS)
#define PH0 { p0_ada<false>(F, 0, LATE_OK ? 2 * (DM / 256) : NMOD / 256, F.vcu, F.G); p0_weights<false>(F, 0, LATE_OK ? P0_ITEMS_IN : P0_ITEMS_ALL - P0_ITEMS_DOWN, F.vcu, F.G); }
#define PH1 { p1_modreduce(F, 0, LATE_OK ? 2 * DM : NMOD); }
#define PH2 { norm_mod_stage(F, F.norm1_g, 0, 1); REFRESH(); norm_mod_rows(F, F.x, LDH); }
#define PH3 { if (PRE_K > 0) { pg8::Gemm g{H, (const bf16*)(args.ws + WS_WIN), M, NP, PRE_K, LDH}; pg8::StaticOrder S; S.init(M, NP, F.G, (int)blockIdx.x); pg8::PRE_EPI E PRE_EPI_INIT; \
              pg8::gemm_phase<pg8::PRE_EPI, pg8::StaticOrder, PG8_ALIGN, PG8_SP2>(F.lds + RING_OFF, g, S, E); __syncthreads(); REFRESH(); } \
              { pg8::Gemm g{H, (const bf16*)(args.ws + WS_WIN), M, NP, DM, LDH}; InProjOrder S; S.init(M, NP, F.G, (int)blockIdx.x); pg8::EpiBf16QKL E{P, NPP, F.fox_q_norm, F.fox_k_norm, (LAS float*)(F.lds + RING_OFF + RING_BYTES)}; \
              pg8::gemm_phase<pg8::EpiBf16QKL, InProjOrder, PG8_ALIGN, PG8_SP2>(F.lds + RING_OFF, g, S, E); }                       \
              for (int r_ = 0; r_ < SIDE_REP; ++r_) { __syncthreads(); REFRESH(); \
              { pg8::Gemm g{H, (const bf16*)(args.ws + WS_WIN) + (size_t)NP * LDWIN, 8 * M, 512, DM / 8, DM / 8}; pg8::StaticOrder S; S.init(8 * M, 512, F.G, (int)blockIdx.x); pg8::EpiScalars E{(float*)(args.ws + WS_FLS), (float*)(args.ws + WS_GG), (float*)(args.ws + WS_GB), F.fox_f_bias, F.gdn_a_log, F.gdn_dt_bias, SEQ, NH}; \
              pg8::gemm_phase<pg8::EpiScalars, pg8::StaticOrder, PG8_ALIGN, PG8_SP2>(F.lds + RING_OFF, g, S, E); } } }
#define PH4 { }
#define PH5 { gdn_chunk_prep(F); }
#define PH6 { if (blockIdx.x < BATCH * NH) { gdn_scan(F, (int)blockIdx.x); VM_WAIT(); __syncthreads(); if (REP(12)) { REFRESH(); gdn_scan(F, (int)blockIdx.x); VM_WAIT(); __syncthreads(); } REFRESH(); } \
              else if (!LATE_OK) { } \
              else if ((int)blockIdx.x >= BATCH * NH + P6_CONV_WGS && (int)blockIdx.x < BATCH * NH + P6_CONV_WGS + P6_ADA_WGS) { p0_ada<true>(F, 2 * (DM / 256), NMOD / 256, (int)blockIdx.x - BATCH * NH - P6_CONV_WGS, P6_ADA_WGS); VM_WAIT(); __syncthreads(); REFRESH(); } \
              else if ((int)blockIdx.x < BATCH * NH + P6_CONV_WGS) { p0_weights<true>(F, P0_ITEMS_IN, P0_ITEMS_ALL - P0_ITEMS_DOWN, (int)blockIdx.x - BATCH * NH, P6_CONV_WGS); VM_WAIT(); __syncthreads(); REFRESH(); } \
              p5_fox(F, (char*)lds + RING_OFF); }
#define PH7 { if (LATE_OK) p1_modreduce(F, 2 * DM, NMOD); p6_gdn_out(F); }
#define PH8 { pg8::Gemm g{MIX, (const bf16*)(args.ws + WS_WOUT), M, DM, DM, LDMIX}; pg8::StaticOrder S; S.init(M, DM, F.G, (int)blockIdx.x); pg8::EpiResGateToBf16 E{F.x, X1, DM, MOD + 2 * DM, NMOD, SEQ}; \
              pg8::gemm_phase<pg8::EpiResGateToBf16, pg8::StaticOrder, PG8_ALIGN, PG8_SP2>(F.lds + RING_OFF, g, S, E); }
#define PH9 { norm_mod_stage(F, F.norm2_g, 3, 4); REFRESH(); norm_mod_rows_b16(F, X1, LDH2); }
#define PH10 { if (PRE_K10 > 0) { pg8::Gemm g{H, (const bf16*)(args.ws + WS_WGU), M, 2 * FF, PRE_K10, LDH2}; pg8::StaticOrder S; S.init(M, 2 * FF, F.G, (int)blockIdx.x); pg8::EpiSwiGLU E{HID, FF}; \
               pg8::gemm_phase<pg8::EpiSwiGLU, pg8::StaticOrder, PG8_ALIGN, PG8_SP2>(F.lds + RING_OFF, g, S, E); __syncthreads(); REFRESH(); } \
                pg8::Gemm g{H, (const bf16*)(args.ws + WS_WGU), M, 2 * FF, DM, LDH2}; pg8::StaticOrder S; S.init(M, 2 * FF, F.G, (int)blockIdx.x); pg8::EpiSwiGLU E{HID, FF}; \
               pg8::gemm_phase<pg8::EpiSwiGLU, pg8::StaticOrder, PG8_ALIGN, PG8_SP2>(F.lds + RING_OFF, g, S, E); \
               { const int nwg_ = (M / 256) * (2 * FF / 256), rem_ = nwg_ % F.G;            \
                 if ((int)blockIdx.x >= rem_) { REFRESH(); p0_weights<true>(F, P0_ITEMS_ALL - P0_ITEMS_DOWN, P0_ITEMS_ALL, (int)blockIdx.x - rem_, F.G - rem_); } } }
#define PH11 { pg8::Gemm g{HID, (const bf16*)(args.ws + WS_WD), M, DM, FF, FF}; pg8::StaticOrder S; S.init(M, DM, F.G, (int)blockIdx.x); pg8::EpiResGateFromBf16 E{X1, F.out, DM, MOD + 5 * DM, NMOD, SEQ}; \
               pg8::gemm_phase<pg8::EpiResGateFromBf16, pg8::StaticOrder, PG8_ALIGN, PG8_SP2>(F.lds + RING_OFF, g, S, E); }
#define PHASE(k, BODY) if (IN(k)) { REFRESH(); BODY if (REP(k)) { for (int rep_ = 0; rep_ < REPN; ++rep_) { xcd_barrier(bar); REFRESH(); BODY } } SEAM(k); }
    PHASE(0, PH0) PHASE(1, PH1) PHASE(2, PH2)
    if (IN(3)) { REFRESH(); PH3 if (REP(3)) { for (int rep_ = 0; rep_ < REPN; ++rep_) { xcd_barrier(bar); REFRESH(); PH3 } } if (IN(5)) xcd_barrier(bar); }
    PHASE(5, PH5) PHASE(6, PH6) PHASE(7, PH7) PHASE(8, PH8) PHASE(9, PH9) PHASE(10, PH10)
    if (IN(11)) { REFRESH(); PH11 }
#undef IN
#undef REFRESH
#undef SEAM
}

extern "C" void kernel_launch(void* const* d_in, const int* in_sizes, int n_in, void* d_out, int out_size, void* d_ws, size_t ws_size, hipStream_t stream) {
    static int grid = 0;
    if (grid == 0) {
        if (n_in != 18 || in_sizes[0] != M * DM || out_size != M * DM || ws_size < WS_END) { fprintf(stderr, "kernel_launch: shape/workspace mismatch (n_in %d, in0 %d, out %d, ws %zu < %zu); nothing launched\n", n_in, n_in > 0 ? in_sizes[0] : -1, out_size, ws_size, (size_t)WS_END); grid = -1; return; }
        int dev = 0, cus = 0, per_cu = 0;
        if (hipGetDevice(&dev) != hipSuccess || hipDeviceGetAttribute(&cus, hipDeviceAttributeMultiprocessorCount, dev) != hipSuccess) { grid = -1; return; }
        if (hipFuncSetAttribute((const void*)hyb_fwd, hipFuncAttributeMaxDynamicSharedMemorySize, LDS_BYTES) != hipSuccess) { fprintf(stderr, "kernel_launch: hipFuncSetAttribute failed\n"); grid = -1; return; }
        if (hipOccupancyMaxActiveBlocksPerMultiprocessor(&per_cu, (const void*)hyb_fwd, NWAVES * 64, LDS_BYTES) != hipSuccess || per_cu < 1)
            fprintf(stderr, "kernel_launch: note: occupancy query reports %d workgroups per CU\n", per_cu);
        (void)hipGetLastError();
        grid = cus;
    }
    if (grid < 0) return;
    if (hipMemsetAsync((char*)d_ws + WS_CTL, 0, CTL_ZERO_BYTES, stream) != hipSuccess) { fprintf(stderr, "kernel_launch: hipMemsetAsync failed\n"); return; }
    Args a{};
    for (int i = 0; i < 18; ++i) a.in[i] = (const float*)d_in[i];
    a.out = (float*)d_out; a.ws = (unsigned char*)d_ws;
#if MK_ONE_LAUNCH
    a.ph_lo = 0; a.ph_hi = N_PHASES;
    hipLaunchKernelGGL(hyb_fwd, dim3(grid), dim3(NWAVES * 64), LDS_BYTES, stream, a);
#else
    for (int ph = 0; ph < N_PHASES; ++ph) {
        a.ph_lo = ph; a.ph_hi = ph + 1;
        hipLaunchKernelGGL(hyb_fwd, dim3(grid), dim3(NWAVES * 64), LDS_BYTES, stream, a);
    }
#endif
    const hipError_t le = hipPeekAtLastError();
    if (le != hipSuccess) fprintf(stderr, "kernel_launch: launch failed: %s\n", hipGetErrorName(le));
}
```
